# Optimizing an MI355X kernel written in HIP

```python
import numpy as np
import jax
import jax.numpy as jnp
from jax import lax

D_MODEL = 1024
BATCH = 32
SEQ = 2048
DEPTH = 1
DEC_BATCH = 8
DEC_SEQ = 2048
PAST_LEN = 128

HEAD_DIM = 64
A_HEADS = 8
A_KV_HEADS = 2
A_GROUP = A_HEADS // A_KV_HEADS
B_HEADS = 8
A_WIDTH = A_HEADS * HEAD_DIM
A_KV_WIDTH = A_KV_HEADS * HEAD_DIM
B_WIDTH = B_HEADS * HEAD_DIM
MIX_WIDTH = A_WIDTH + B_WIDTH
WINDOW = 128
A_BLOCK = 128
ROT_DIM = HEAD_DIM // 4
ROPE_THETA = 500000.0
GRID_W = 64
NA_ROWS_MAX = 8
NA_COLS = 16
NA_COL_BLOCK = 16
NA_KEY_COLS = 32
NA_N_COL_BLOCKS = GRID_W // NA_COL_BLOCK
PLE_DIM = 256
EPS = 1e-6
IN_WIDTHS = (A_WIDTH, A_KV_WIDTH, A_KV_WIDTH, A_WIDTH, B_WIDTH, B_WIDTH, B_WIDTH, B_WIDTH)
IN_WIDTH = sum(IN_WIDTHS)
IN_SPLITS = [int(v) for v in np.cumsum(IN_WIDTHS)[:-1]]

kernel_name = 'hymba_style_window_gqa_neighbourhood_encoder'


def rms_norm(x, g):
    xf = x.astype(jnp.float32)
    y = xf * lax.rsqrt(jnp.mean(xf * xf, axis=-1, keepdims=True) + EPS)
    return (y * g.astype(jnp.float32)).astype(x.dtype)


def partial_rope(x, positions):
    inv_freq = jnp.power(ROPE_THETA, -jnp.arange(0, ROT_DIM, 2, dtype=jnp.float32) / ROT_DIM)
    ang = positions.astype(jnp.float32)[:, None] * inv_freq[None, :]
    cos = jnp.cos(ang)[:, None, :]
    sin = jnp.sin(ang)[:, None, :]
    xr = x[..., :ROT_DIM].astype(jnp.float32)
    x1, x2 = xr[..., :ROT_DIM // 2], xr[..., ROT_DIM // 2:]
    rot = jnp.concatenate([x1 * cos - x2 * sin, x2 * cos + x1 * sin], axis=-1)
    return jnp.concatenate([rot.astype(x.dtype), x[..., ROT_DIM:]], axis=-1)


def windowed_gqa_sink(q, k, v, sink):
    b, s = q.shape[0], q.shape[1]
    nb = s // A_BLOCK
    span = A_BLOCK + 2 * WINDOW
    pad = ((0, 0), (WINDOW, WINDOW), (0, 0), (0, 0))
    kp = jnp.pad(k, pad)
    vp = jnp.pad(v, pad)
    qi = np.arange(A_BLOCK)[:, None]
    si = np.arange(span)[None, :]
    band = np.abs(si - WINDOW - qi) <= WINDOW
    sink_f = sink.astype(jnp.float32).reshape(A_KV_HEADS, A_GROUP)[None, :, :, None, None]
    scale = HEAD_DIM ** -0.5

    def block(j):
        start = j * A_BLOCK
        qb = lax.dynamic_slice_in_dim(q, start, A_BLOCK, axis=1)
        qb = qb.reshape(b, A_BLOCK, A_KV_HEADS, A_GROUP, HEAD_DIM)
        kb = lax.dynamic_slice_in_dim(kp, start, span, axis=1)
        vb = lax.dynamic_slice_in_dim(vp, start, span, axis=1)
        sc = jnp.einsum('bqkgd,bskd->bkgqs', qb, kb).astype(jnp.float32) * scale
        kpos = start - WINDOW + jnp.arange(span)
        valid = band & ((kpos >= 0) & (kpos < s))[None, :]
        sc = jnp.where(valid, sc, -jnp.inf)
        m = jnp.maximum(jnp.max(sc, axis=-1, keepdims=True), sink_f)
        e = jnp.exp(sc - m)
        denom = jnp.sum(e, axis=-1, keepdims=True) + jnp.exp(sink_f - m)
        pr = (e / denom).astype(vb.dtype)
        o = jnp.einsum('bkgqs,bskd->bqkgd', pr, vb)
        return o.reshape(b, A_BLOCK, A_WIDTH)

    out = lax.map(block, jnp.arange(nb))
    return out.transpose(1, 0, 2, 3).reshape(b, s, A_WIDTH)


def neighbourhood_attn(q, k, v, rpb):
    b, s = q.shape[0], q.shape[1]
    rows = s // GRID_W
    wr = min(NA_ROWS_MAX, rows)
    qg = q.reshape(b, rows, GRID_W, B_HEADS, HEAD_DIM)
    kg = k.reshape(b, rows, GRID_W, B_HEADS, HEAD_DIM)
    vg = v.reshape(b, rows, GRID_W, B_HEADS, HEAD_DIM)
    cols = np.arange(GRID_W)
    col_start = np.clip(cols - NA_COLS // 2, 0, GRID_W - NA_COLS)
    blk_start = np.clip(np.arange(NA_N_COL_BLOCKS) * NA_COL_BLOCK - NA_COLS // 2,
                        0, GRID_W - NA_KEY_COLS)
    key_cols = blk_start[:, None] + np.arange(NA_KEY_COLS)[None, :]
    q_cols = cols.reshape(NA_N_COL_BLOCKS, NA_COL_BLOCK)
    qs = col_start.reshape(NA_N_COL_BLOCKS, NA_COL_BLOCK)[:, :, None]
    kc = key_cols[:, None, :]
    col_valid = (kc >= qs) & (kc < qs + NA_COLS)
    dcol = np.clip(kc - q_cols[:, :, None], -(NA_COLS - 1), NA_COLS - 1) + NA_COLS - 1
    rpb_cols = rpb[:, :, dcol]
    mask = col_valid[:, None, :, None, :]
    scale = HEAD_DIM ** -0.5

    def row(r):
        rs = jnp.clip(r - wr // 2, 0, rows - wr)
        qr = lax.dynamic_index_in_dim(qg, r, axis=1, keepdims=False)
        qr = qr.reshape(b, NA_N_COL_BLOCKS, NA_COL_BLOCK, B_HEADS, HEAD_DIM)
        kr = lax.dynamic_slice_in_dim(kg, rs, wr, axis=1)
        vr = lax.dynamic_slice_in_dim(vg, rs, wr, axis=1)
        kb = kr[:, :, key_cols]
        vb = vr[:, :, key_cols]
        sc = jnp.einsum('bnqhd,banchd->bnhqac', qr, kb).astype(jnp.float32) * scale
        drow = rs + jnp.arange(wr) - r + NA_ROWS_MAX - 1
        bias = rpb_cols[:, drow].transpose(2, 0, 3, 1, 4)
        sc = jnp.where(mask, sc + bias.astype(jnp.float32), -jnp.inf)
        sc = sc.reshape(b, NA_N_COL_BLOCKS, B_HEADS, NA_COL_BLOCK, wr * NA_KEY_COLS)
        pr = jax.nn.softmax(sc, axis=-1)
        pr = pr.reshape(b, NA_N_COL_BLOCKS, B_HEADS, NA_COL_BLOCK, wr, NA_KEY_COLS).astype(vb.dtype)
        o = jnp.einsum('bnhqac,banchd->bnqhd', pr, vb)
        return o.reshape(b, GRID_W, B_WIDTH)

    out = lax.map(row, jnp.arange(rows))
    return out.transpose(1, 0, 2, 3).reshape(b, s, B_WIDTH)


def encoder_layer(x, p, norm_w, w_in, q_norm_a, k_norm_a, sink_a,
                  q_norm_b, k_norm_b, rpb_b, w_out, w_ple, w_ple_gate):
    b, s, _ = x.shape
    h = rms_norm(x, norm_w)
    proj = h @ w_in
    q_a, k_a, v_a, g_a, q_b, k_b, v_b, g_b = jnp.split(proj, IN_SPLITS, axis=-1)
    pos = jnp.arange(s)
    q_a = partial_rope(rms_norm(q_a.reshape(b, s, A_HEADS, HEAD_DIM), q_norm_a), pos)
    k_a = partial_rope(rms_norm(k_a.reshape(b, s, A_KV_HEADS, HEAD_DIM), k_norm_a), pos)
    v_a = v_a.reshape(b, s, A_KV_HEADS, HEAD_DIM)
    o_a = windowed_gqa_sink(q_a, k_a, v_a, sink_a) * jax.nn.silu(g_a)
    q_b = rms_norm(q_b.reshape(b, s, B_HEADS, HEAD_DIM), q_norm_b)
    k_b = rms_norm(k_b.reshape(b, s, B_HEADS, HEAD_DIM), k_norm_b)
    v_b = v_b.reshape(b, s, B_HEADS, HEAD_DIM)
    o_b = neighbourhood_attn(q_b, k_b, v_b, rpb_b) * jax.nn.silu(g_b)
    x = x + jnp.concatenate([o_a, o_b], axis=-1) @ w_out
    gate = jax.nn.sigmoid(x @ w_ple_gate)
    return x + (p @ w_ple) * gate


def run_trunk(x, p, norm_w, w_in, q_norm_a, k_norm_a, sink_a,
              q_norm_b, k_norm_b, rpb_b, w_out, w_ple, w_ple_gate):
    for i in range(DEPTH):
        x = encoder_layer(x, p[i], norm_w[i], w_in[i], q_norm_a[i], k_norm_a[i], sink_a[i],
                          q_norm_b[i], k_norm_b[i], rpb_b[i], w_out[i], w_ple[i], w_ple_gate[i])
    return x


def setup_inputs(seed: int = 0) -> dict:
    key = jax.random.key(seed)
    ks = jax.random.split(key, 16)
    f32 = jnp.float32
    nrm = jax.random.normal
    return {
        'x_prompt': nrm(ks[0], (BATCH, SEQ, D_MODEL), f32),
        'x_sample': nrm(ks[1], (DEC_BATCH, DEC_SEQ, D_MODEL), f32),
        'p_prompt': nrm(ks[2], (DEPTH, BATCH, SEQ, PLE_DIM), f32),
        'p_sample': nrm(ks[3], (DEPTH, DEC_BATCH, DEC_SEQ, PLE_DIM), f32),
        'norm_w': 1.0 + 0.02 * nrm(ks[4], (DEPTH, D_MODEL), f32),
        'w_in': nrm(ks[5], (DEPTH, D_MODEL, IN_WIDTH), f32) * D_MODEL ** -0.5,
        'q_norm_a': 1.0 + 0.02 * nrm(ks[6], (DEPTH, HEAD_DIM), f32),
        'k_norm_a': 1.0 + 0.02 * nrm(ks[7], (DEPTH, HEAD_DIM), f32),
        'sink_a': 0.5 * nrm(ks[8], (DEPTH, A_HEADS), f32),
        'q_norm_b': 1.0 + 0.02 * nrm(ks[9], (DEPTH, HEAD_DIM), f32),
        'k_norm_b': 1.0 + 0.02 * nrm(ks[10], (DEPTH, HEAD_DIM), f32),
        'rpb_b': 0.1 * nrm(ks[11], (DEPTH, B_HEADS, 2 * NA_ROWS_MAX - 1, 2 * NA_COLS - 1), f32),
        'w_out': nrm(ks[12], (DEPTH, MIX_WIDTH, D_MODEL), f32) * MIX_WIDTH ** -0.5,
        'w_ple': nrm(ks[13], (DEPTH, PLE_DIM, D_MODEL), f32) * PLE_DIM ** -0.5,
        'w_ple_gate': nrm(ks[14], (DEPTH, D_MODEL, D_MODEL), f32) * D_MODEL ** -0.5,
    }


def reference(x_prompt, x_sample, p_prompt, p_sample, norm_w, w_in, q_norm_a, k_norm_a, sink_a,
              q_norm_b, k_norm_b, rpb_b, w_out, w_ple, w_ple_gate):
    y_prompt = run_trunk(x_prompt, p_prompt, norm_w, w_in, q_norm_a, k_norm_a, sink_a,
                         q_norm_b, k_norm_b, rpb_b, w_out, w_ple, w_ple_gate)
    y_sample = run_trunk(x_sample, p_sample, norm_w, w_in, q_norm_a, k_norm_a, sink_a,
                         q_norm_b, k_norm_b, rpb_b, w_out, w_ple, w_ple_gate)
    return (y_prompt, y_sample)
```

```cpp
#include <hip/hip_runtime.h>
#include <hip/hip_cooperative_groups.h>
#include <cstdio>
#include <cstdint>
#include <cmath>
namespace cg = cooperative_groups;
namespace pg8 {
#define PG8_LAS __attribute__((address_space(3)))
typedef unsigned short bf16_t;
typedef short bf16x8 __attribute__((ext_vector_type(8)));
typedef float f32x4 __attribute__((ext_vector_type(4)));
typedef unsigned u32x4 __attribute__((ext_vector_type(4)));
constexpr int BM = 256, BK = 64, HALF = 128, HTB = HALF * BK * 2  , STAGE_BYTES = 8 * HTB, NXCD = 8, WGM = 8;

__host__ __device__ __forceinline__ int lds_byte(int r, int c) { const int st = (r >> 4) * 2 + (c >> 5), rr = r & 15, cc = c & 31, ob = rr * 64 + cc * 2; return st * 1024 + (ob ^ (((ob >> 9) & 1) << 5)); }
__host__ __device__ __forceinline__ void stage_rc(int b, int& R, int& C) { const int st = b / 1024, sb = b % 1024, swz = sb ^ (((sb >> 9) & 1) << 5); R = (st >> 1) * 16 + swz / 64; C = (st & 1) * 32 + (swz % 64) / 2; }
__host__ __device__ __forceinline__ int perm32(int rho) { const int n = rho >> 4, i = rho & 15; return 8 * (i >> 2) + 4 * n + (i & 3); }

struct Unit { int pm, pn; };
struct Gemm { const bf16_t* A; const bf16_t* Bt; int M, N, K; };

struct StaticOrder {
    int nM, nN, nwg, G, c, reps = 1, i0 = 0, i1 = 1 << 30;
    __host__ __device__ void init(int M, int N, int G_, int c_) { nM = M / BM; nN = N / BM; nwg = nM * nN; G = G_; c = c_; }
    __host__ __device__ bool next(int ii, Unit& u) const {
        const int i = ii + i0; if (i >= i1) return false;
        const long L = (long)i * G + c; if (L >= (long)nwg * reps) return false;
        int wgid = (int)(L % nwg); { const int q = nwg / NXCD, r = nwg % NXCD, xcd = wgid % NXCD, off = wgid / NXCD; wgid = (xcd < r ? xcd * (q + 1) : r * (q + 1) + (xcd - r) * q) + off; }
        const int nig = WGM * nN, gid = wgid / nig, fm = gid * WGM, gsz = (nM - fm) < WGM ? (nM - fm) : WGM;
        u.pm = fm + ((wgid % nig) % gsz); u.pn = (wgid % nig) / gsz; return true;
    }
    __device__ __forceinline__ void a_ready(const Unit&) const {}
    __device__ __forceinline__ void done(const Unit&) const {}
};

__device__ __forceinline__ unsigned cvt_pk_bf16(float lo, float hi) { unsigned r; asm volatile("v_cvt_pk_bf16_f32 %0, %1, %2" : "=v"(r) : "v"(lo), "v"(hi)); return r; }
typedef float f32x2 __attribute__((ext_vector_type(2)));
template <bool F16> __device__ __forceinline__ f32x4 mma16(bf16x8 a, bf16x8 b, f32x4 c) {
    if constexpr (F16) { typedef _Float16 h8 __attribute__((ext_vector_type(8))); return __builtin_amdgcn_mfma_f32_16x16x32_f16(__builtin_bit_cast(h8, a), __builtin_bit_cast(h8, b), c, 0, 0, 0); }
    else return __builtin_amdgcn_mfma_f32_16x16x32_bf16(a, b, c, 0, 0, 0);
}
template <class Epi, class Sched, bool ALIGN_EPI = false, bool SP2 = false, bool F16 = false>
__device__ __forceinline__ void gemm_phase(PG8_LAS unsigned char* lds, const Gemm g, const Sched& S, const Epi& E) {
    const int tid = threadIdx.x, wid = __builtin_amdgcn_readfirstlane(tid >> 6), lane = tid & 63, wr = wid >> 2, wc = wid & 3, fr = lane & 15, fq = lane >> 4;
    const int K = g.K, nt = K / BK;
    unsigned voffA[2], voffB[2];
#pragma unroll
    for (int i = 0; i < 2; ++i) { int R, C; stage_rc(tid * 16 + i * 8192, R, C); const int Rb = Epi::PERM ? ((R & ~31) + perm32(R & 31)) : R;
        voffA[i] = (unsigned)(R * K + C) * 2u; voffB[i] = (unsigned)(Rb * K + C) * 2u; }
    const size_t kstep = (size_t)(BK * 2);
    const size_t hstep = (size_t)HALF * K * 2;
    const size_t tstep = 2 * hstep;
    const unsigned ldsw = (unsigned)wid * 1024u;
    const int aoff = lds_byte(wr * 64 + fr, fq * 8), boff = lds_byte(wc * 32 + fr, fq * 8);
#define PG8_SA(b, h) (((b) * 2 + (h)) * HTB)
#define PG8_SB(b, h) ((4 + (b) * 2 + (h)) * HTB)
#define PG8_STAGE(bufoff, gbase, voff) do { _Pragma("unroll") for (int _i = 0; _i < 2; ++_i) \
        __builtin_amdgcn_global_load_lds((const unsigned*)((const char*)(gbase) + (voff)[_i]), (PG8_LAS unsigned*)(lds + (bufoff) + ldsw + _i * 8192), 16, 0, 0); } while (0)
#define PG8_LDA(dst, b, h) do { _Pragma("unroll") for (int m = 0; m < 4; ++m) _Pragma("unroll") for (int k = 0; k < 2; ++k) dst[m][k] = *(const PG8_LAS bf16x8*)(lds + PG8_SA(b, h) + aoff + m * 2048 + k * 1024); } while (0)
#define PG8_LDB(dst, b, h) do { _Pragma("unroll") for (int n = 0; n < 2; ++n) _Pragma("unroll") for (int k = 0; k < 2; ++k) dst[n][k] = *(const PG8_LAS bf16x8*)(lds + PG8_SB(b, h) + boff + n * 2048 + k * 1024); } while (0)
#define PG8_MMA(ai, bj, At, Bt) do { __builtin_amdgcn_s_setprio(1); _Pragma("unroll") for (int m = 0; m < 4; ++m) _Pragma("unroll") for (int n = 0; n < 2; ++n) _Pragma("unroll") for (int k = 0; k < 2; ++k) \
        acc[ai][bj][m][n] = mma16<F16>(Bt[n][k], At[m][k], acc[ai][bj][m][n]); __builtin_amdgcn_s_setprio(0); } while (0)
#define PG8_WAIT_V(n) asm volatile("s_waitcnt vmcnt(" #n ")" ::: "memory")
#define PG8_WAIT_L(n) asm volatile("s_waitcnt lgkmcnt(" #n ")" ::: "memory")
#define PG8_BAR __builtin_amdgcn_s_barrier()
#define PG8_SCHED __builtin_amdgcn_sched_barrier(0)
    Unit cur, nxt; int ui = 0;
    if (!S.next(0, cur)) return;
    f32x4 acc[2][2][4][2];
#pragma unroll
    for (int a = 0; a < 2; ++a)
#pragma unroll
        for (int b = 0; b < 2; ++b)
#pragma unroll
            for (int m = 0; m < 4; ++m)
#pragma unroll
                for (int n = 0; n < 2; ++n) acc[a][b][m][n] = (f32x4){0.f, 0.f, 0.f, 0.f};
    bf16x8 At[4][2], B0[2][2], B1[2][2];
    const char* cA = (const char*)g.A + (size_t)cur.pm * tstep; const char* cB = (const char*)g.Bt + (size_t)cur.pn * tstep;
    S.a_ready(cur);
    if constexpr (SP2) {
        PG8_STAGE(PG8_SB(0, 0), cB, voffB); PG8_STAGE(PG8_SB(0, 1), cB + hstep, voffB); PG8_STAGE(PG8_SA(0, 0), cA, voffA); PG8_STAGE(PG8_SA(0, 1), cA + hstep, voffA);
        if (wr == 1) PG8_BAR;
        PG8_WAIT_V(2); PG8_BAR;
        PG8_STAGE(PG8_SB(1, 0), cB + kstep, voffB); PG8_STAGE(PG8_SA(1, 0), cA + kstep, voffA); PG8_STAGE(PG8_SB(1, 1), cB + hstep + kstep, voffB);
        PG8_WAIT_V(6); PG8_BAR;
    } else {
        PG8_STAGE(PG8_SB(0, 0), cB, voffB); PG8_STAGE(PG8_SA(0, 0), cA, voffA); PG8_STAGE(PG8_SB(0, 1), cB + hstep, voffB); PG8_STAGE(PG8_SA(0, 1), cA + hstep, voffA);
        if (wr == 1) PG8_BAR;
        PG8_WAIT_V(4); PG8_BAR;
        PG8_STAGE(PG8_SB(1, 0), cB + kstep, voffB); PG8_STAGE(PG8_SA(1, 0), cA + kstep, voffA); PG8_STAGE(PG8_SB(1, 1), cB + hstep + kstep, voffB);
        PG8_WAIT_V(6); PG8_BAR;
    }
    for (;;) {
        const bool has_next = S.next(ui + 1, nxt);
        const char* nA = has_next ? (const char*)g.A + (size_t)nxt.pm * tstep : cA; const char* nB = has_next ? (const char*)g.Bt + (size_t)nxt.pn * tstep : cB;
#pragma unroll 1
        for (int t = 0; t < nt; t += 2) {
            const bool last = (t == nt - 2);
            if constexpr (Epi::KPF) E.kpf(cur, t >> 1, tid, lds + STAGE_BYTES);
            const char* a1 = cA + (size_t)(t + 1) * kstep;
            const char* a2 = last ? nA : cA + (size_t)(t + 2) * kstep; const char* b2 = last ? nB : cB + (size_t)(t + 2) * kstep;
            const char* a3 = a2 + kstep; const char* b3 = b2 + kstep;
            if (last && has_next) S.a_ready(nxt);
            if constexpr (SP2) {
            PG8_LDB(B0, 0, 0); PG8_LDB(B1, 0, 1); PG8_SCHED; PG8_LDA(At, 0, 0); PG8_STAGE(PG8_SA(1, 1), a1 + hstep, voffA);
            PG8_WAIT_V(8); PG8_WAIT_L(0); PG8_BAR; PG8_MMA(0, 0, At, B0); PG8_MMA(0, 1, At, B1); PG8_BAR; PG8_SCHED;
            PG8_LDA(At, 0, 1); PG8_STAGE(PG8_SB(0, 0), b2, voffB); PG8_STAGE(PG8_SB(0, 1), b2 + hstep, voffB); PG8_STAGE(PG8_SA(0, 0), a2, voffA);
            PG8_WAIT_V(8); PG8_WAIT_L(0); PG8_BAR; PG8_MMA(1, 0, At, B0); PG8_MMA(1, 1, At, B1); PG8_BAR; PG8_SCHED;
            PG8_LDB(B0, 1, 0); PG8_LDB(B1, 1, 1); PG8_SCHED; PG8_LDA(At, 1, 0); PG8_STAGE(PG8_SA(0, 1), a2 + hstep, voffA);
            PG8_WAIT_V(8); PG8_WAIT_L(0); PG8_BAR; PG8_MMA(0, 0, At, B0); PG8_MMA(0, 1, At, B1); PG8_BAR; PG8_SCHED;
            PG8_LDA(At, 1, 1); PG8_STAGE(PG8_SB(1, 0), b3, voffB); PG8_STAGE(PG8_SB(1, 1), b3 + hstep, voffB); PG8_STAGE(PG8_SA(1, 0), a3, voffA);
            PG8_WAIT_V(8); PG8_WAIT_L(0); PG8_BAR; PG8_MMA(1, 0, At, B0); PG8_MMA(1, 1, At, B1); PG8_BAR; PG8_SCHED;
            } else {
            PG8_LDB(B0, 0, 0); PG8_SCHED; PG8_LDA(At, 0, 0); PG8_STAGE(PG8_SA(1, 1), a1 + hstep, voffA);
            PG8_WAIT_L(8); PG8_BAR; PG8_WAIT_L(0); PG8_MMA(0, 0, At, B0); PG8_BAR; PG8_SCHED;
            PG8_LDB(B1, 0, 1); PG8_STAGE(PG8_SB(0, 0), b2, voffB);
            PG8_BAR; PG8_WAIT_L(0); PG8_MMA(0, 1, At, B1); PG8_BAR;
            PG8_LDA(At, 0, 1); PG8_STAGE(PG8_SA(0, 0), a2, voffA);
            PG8_BAR; PG8_WAIT_L(0); PG8_MMA(1, 0, At, B0); PG8_BAR; PG8_SCHED;
            PG8_STAGE(PG8_SB(0, 1), b2 + hstep, voffB);
            PG8_WAIT_V(6); PG8_BAR; PG8_MMA(1, 1, At, B1); PG8_BAR;
            PG8_LDB(B0, 1, 0); PG8_SCHED; PG8_LDA(At, 1, 0); PG8_STAGE(PG8_SA(0, 1), a2 + hstep, voffA);
            PG8_WAIT_L(8); PG8_BAR; PG8_WAIT_L(0); PG8_MMA(0, 0, At, B0); PG8_BAR; PG8_SCHED;
            PG8_LDB(B1, 1, 1); PG8_STAGE(PG8_SB(1, 0), b3, voffB);
            PG8_BAR; PG8_WAIT_L(0); PG8_MMA(0, 1, At, B1); PG8_BAR;
            PG8_LDA(At, 1, 1); PG8_STAGE(PG8_SA(1, 0), a3, voffA);
            PG8_BAR; PG8_WAIT_L(0); PG8_MMA(1, 0, At, B0); PG8_BAR; PG8_SCHED;
            PG8_STAGE(PG8_SB(1, 1), b3 + hstep, voffB);
            PG8_WAIT_V(6); PG8_BAR; PG8_MMA(1, 1, At, B1); PG8_BAR;
            }
        }
        if constexpr (ALIGN_EPI) { if (wr == 0) PG8_BAR; }
        if constexpr (!Epi::AFTER_DRAIN) { E(acc, cur, wr, wc, fr, fq); S.done(cur); }
        if (!has_next) break;
#pragma unroll
        for (int a = 0; a < 2; ++a)
#pragma unroll
            for (int b = 0; b < 2; ++b)
#pragma unroll
                for (int m = 0; m < 4; ++m)
#pragma unroll
                    for (int n = 0; n < 2; ++n) acc[a][b][m][n] = (f32x4){0.f, 0.f, 0.f, 0.f};
        cur = nxt; cA = nA; cB = nB; ++ui;
        if constexpr (ALIGN_EPI) { if (wr == 1) PG8_BAR; }
    }
    PG8_WAIT_V(0);
    if constexpr (!ALIGN_EPI) { if (wr == 0) PG8_BAR; }
    PG8_BAR;
    if constexpr (Epi::AFTER_DRAIN) { E.fused(acc, cur, wr, wc, fr, fq, lds, wid, lane); S.done(cur); }
#undef PG8_SA
#undef PG8_SB
#undef PG8_STAGE
#undef PG8_LDA
#undef PG8_LDB
#undef PG8_MMA
#undef PG8_WAIT_V
#undef PG8_WAIT_L
#undef PG8_BAR
#undef PG8_SCHED
}
}

#define LAS __attribute__((address_space(3)))
typedef unsigned short bf16;
typedef unsigned u32x4 __attribute__((ext_vector_type(4)));
typedef unsigned u32x2 __attribute__((ext_vector_type(2)));
typedef float f32x4 __attribute__((ext_vector_type(4)));
typedef short bf16x8 __attribute__((ext_vector_type(8)));
typedef short s16x4 __attribute__((ext_vector_type(4)));

constexpr int DM = 1024, SEQ = 2048, NBATCH = 40, MTOK = NBATCH * SEQ, MPROMPT = 32 * SEQ;
constexpr int NIN = 3328, PLE = 256;
constexpr int NPJ = 2048;
constexpr int C_QA = 0, C_GA = 512, C_QB = 1024, C_GB = 1536;
constexpr float EPS = 1e-6f, L2E = 1.4426950408889634f;
constexpr int NWAVES = 8, NTHREADS = 512;
constexpr int LDS_BYTES = 155648;

constexpr size_t WS_WIN = 0;
constexpr size_t WS_WOUT = WS_WIN + (size_t)NIN * DM * 2;
constexpr size_t WS_WGATE = WS_WOUT + (size_t)DM * DM * 2;
constexpr size_t WS_WPLE = WS_WGATE + (size_t)DM * DM * 2;
constexpr size_t WS_ROPE = WS_WPLE + (size_t)DM * PLE * 2;
constexpr size_t WS_RINV = WS_ROPE + 2048 * 16 * 4;
constexpr size_t WS_CTL = 15u << 20, CTL_BYTES = 16384;
constexpr size_t WS_XN = 16u << 20;
constexpr size_t WS_PBF = WS_XN + (size_t)MTOK * DM * 2;
constexpr size_t WS_PROJ = WS_PBF + (size_t)MTOK * PLE * 2;
constexpr size_t WS_KB = WS_PROJ + (size_t)MTOK * NPJ * 2;
constexpr size_t WS_VB = WS_KB + (size_t)MTOK * 512 * 2;
constexpr size_t WS_KA = WS_VB + (size_t)MTOK * 512 * 2;
constexpr size_t WS_VA = WS_KA + (size_t)MTOK * 128 * 2;
constexpr size_t WS_MIX = WS_VA + (size_t)MTOK * 128 * 2;
constexpr size_t WS_END = WS_MIX + (size_t)MTOK * DM * 2;
static_assert(WS_RINV + (size_t)MTOK * 4 <= WS_CTL && WS_CTL + CTL_BYTES <= WS_XN, "ws map");

__device__ __forceinline__ unsigned f2bf(float f) { unsigned u = __builtin_bit_cast(unsigned, f); return (u + 0x7fffu + ((u >> 16) & 1u)) >> 16; }
typedef float f32x2_t __attribute__((ext_vector_type(2))); typedef __bf16 bf16x2_t __attribute__((ext_vector_type(2)));
__device__ __forceinline__ unsigned pk2(float lo, float hi) { f32x2_t v = {lo, hi}; bf16x2_t b = __builtin_convertvector(v, bf16x2_t); return __builtin_bit_cast(unsigned, b); }
typedef _Float16 f16x2_t __attribute__((ext_vector_type(2)));
__device__ __forceinline__ unsigned pkh2(float lo, float hi) { f32x2_t v = {lo, hi}; f16x2_t h = __builtin_convertvector(v, f16x2_t); return __builtin_bit_cast(unsigned, h); }
__device__ __forceinline__ float hlo(unsigned v) { return (float)__builtin_bit_cast(f16x2_t, v)[0]; }
__device__ __forceinline__ float hhi(unsigned v) { return (float)__builtin_bit_cast(f16x2_t, v)[1]; }
__device__ __forceinline__ float bf2f(unsigned short v) { return __builtin_bit_cast(float, (unsigned)v << 16); }
__device__ __forceinline__ float bflo(unsigned v) { return __builtin_bit_cast(float, v << 16); }
__device__ __forceinline__ float bfhi(unsigned v) { return __builtin_bit_cast(float, v & 0xffff0000u); }
__device__ __forceinline__ float fast_exp2(float x) { return __builtin_amdgcn_exp2f(x); }
__device__ __forceinline__ float fast_rcp(float x) { return __builtin_amdgcn_rcpf(x); }
__device__ __forceinline__ float sigmoidf_(float x) { return fast_rcp(1.0f + fast_exp2(-x * L2E)); }

struct EpiProj {
    static constexpr bool PERM = true, AFTER_DRAIN = false, KPF = false;
    bf16* P; bf16* KA; bf16* VA; bf16* KB; bf16* VB; const float* rinv; const float* qna; const float* kna; const float* qnb; const float* knb; const float* rope;
    __device__ __forceinline__ void operator()(const f32x4 (&acc)[2][2][4][2], const pg8::Unit& u, int wr, int wc, int fr, int fq) const {
        const int pn = u.pn;
        int type = 0; const float* nw = qna; bool rope_on = false; float sc = 1.f;
        bf16* dst = P; int hm_heads = 0, hm_head = 0, tcol = 0;
        if (pn <= 1) { type = 2; nw = qna; rope_on = true; sc = 0.125f; tcol = C_QA + pn * 256 + 64 * wc; }
        else if (pn == 2) { if (wc < 2) { type = 2; nw = kna; rope_on = true; dst = KA; hm_heads = 2; hm_head = wc; } else { dst = VA; hm_heads = 2; hm_head = wc - 2; } }
        else if (pn <= 4) { type = 1; tcol = C_GA + (pn - 3) * 256 + 64 * wc; }
        else if (pn <= 6) { type = 2; nw = qnb; sc = 0.125f; tcol = C_QB + (pn - 5) * 256 + 64 * wc; }
        else if (pn <= 8) { type = 2; nw = knb; dst = KB; hm_heads = 8; hm_head = (pn - 7) * 4 + wc; }
        else if (pn <= 10) { dst = VB; hm_heads = 8; hm_head = (pn - 9) * 4 + wc; }
        else { type = 1; tcol = C_GB + (pn - 11) * 256 + 64 * wc; }
        f32x4 w[2][2];
#pragma unroll
        for (int bj = 0; bj < 2; ++bj)
#pragma unroll
            for (int n = 0; n < 2; ++n) w[bj][n] = *(const f32x4*)(nw + 32 * bj + 8 * fq + 4 * n) * sc;
#pragma unroll
        for (int ai = 0; ai < 2; ++ai)
#pragma unroll
            for (int m = 0; m < 4; ++m) {
                const int row = u.pm * 256 + ai * 128 + wr * 64 + m * 16 + fr;
                const float rs = rinv[row];
                f32x4 v[2][2];
#pragma unroll
                for (int bj = 0; bj < 2; ++bj)
#pragma unroll
                    for (int n = 0; n < 2; ++n) v[bj][n] = acc[ai][bj][m][n] * rs;
                if (type == 2) {
                    float ss = 0.f;
#pragma unroll
                    for (int bj = 0; bj < 2; ++bj)
#pragma unroll
                        for (int n = 0; n < 2; ++n) { const f32x4 x = v[bj][n]; ss += (x[0] * x[0] + x[1] * x[1]) + (x[2] * x[2] + x[3] * x[3]); }
                    ss += __shfl_xor(ss, 16); ss += __shfl_xor(ss, 32);
                    const float rinv = __builtin_amdgcn_rsqf(ss * (1.0f / 64.0f) + EPS);
#pragma unroll
                    for (int bj = 0; bj < 2; ++bj)
#pragma unroll
                        for (int n = 0; n < 2; ++n) v[bj][n] = v[bj][n] * rinv * w[bj][n];
                    if (rope_on) {
                        const int pos = row & (SEQ - 1);
                        const float* rp = rope + pos * 16;
#pragma unroll
                        for (int n = 0; n < 2; ++n) {
                            const f32x4 c = *(const f32x4*)(rp + 4 * n), s = *(const f32x4*)(rp + 8 + 4 * n);
                            f32x4 pv;
#pragma unroll
                            for (int e = 0; e < 4; ++e) pv[e] = __shfl_xor(v[0][n][e], 16);
                            if (fq == 0) v[0][n] = v[0][n] * c - pv * s;
                            else if (fq == 1) v[0][n] = v[0][n] * c + pv * s;
                        }
                    }
                } else if (type == 1) {
#pragma unroll
                    for (int bj = 0; bj < 2; ++bj)
#pragma unroll
                        for (int n = 0; n < 2; ++n)
#pragma unroll
                            for (int e = 0; e < 4; ++e) { const float x = v[bj][n][e]; v[bj][n][e] = x * sigmoidf_(x); }
                }
                bf16* rowp = hm_heads ? dst + ((size_t)((row >> 11) * hm_heads + hm_head) * SEQ + (row & (SEQ - 1))) * 64 + 8 * fq : dst + (size_t)row * NPJ + tcol + 8 * fq;
#pragma unroll
                for (int bj = 0; bj < 2; ++bj) {
                    u32x4 o; o.x = pk2(v[bj][0][0], v[bj][0][1]); o.y = pk2(v[bj][0][2], v[bj][0][3]); o.z = pk2(v[bj][1][0], v[bj][1][1]); o.w = pk2(v[bj][1][2], v[bj][1][3]);
                    *(u32x4*)(rowp + 32 * bj) = o;
                }
            }
    }
};
struct EpiPlain {
    static constexpr bool PERM = true, AFTER_DRAIN = false, KPF = false;
    bf16* O; int ldc;
    __device__ __forceinline__ void operator()(const f32x4 (&acc)[2][2][4][2], const pg8::Unit& u, int wr, int wc, int fr, int fq) const {
        const int row0 = u.pm * 256 + wr * 64 + fr, col0 = u.pn * 256 + wc * 32 + 8 * fq;
#pragma unroll
        for (int ai = 0; ai < 2; ++ai)
#pragma unroll
            for (int m = 0; m < 4; ++m) { bf16* rowp = O + (size_t)(row0 + ai * 128 + m * 16) * ldc + col0;
#pragma unroll
                for (int bj = 0; bj < 2; ++bj) { const f32x4 v0 = acc[ai][bj][m][0], v1 = acc[ai][bj][m][1];
                    u32x4 o; o.x = pk2(v0[0], v0[1]); o.y = pk2(v0[2], v0[3]); o.z = pk2(v1[0], v1[1]); o.w = pk2(v1[2], v1[3]);
                    *(u32x4*)(rowp + bj * 128) = o; } }
    }
};
struct EpiRes {
    static constexpr bool PERM = true, AFTER_DRAIN = false, KPF = false;
    bf16* xh;
    __device__ __forceinline__ void operator()(const f32x4 (&acc)[2][2][4][2], const pg8::Unit& u, int wr, int wc, int fr, int fq) const {
        const int row0 = u.pm * 256 + wr * 64 + fr, col0 = u.pn * 256 + wc * 32 + 8 * fq;
        bf16* hbase = xh + (size_t)row0 * DM + col0;
#pragma unroll
        for (int ai = 0; ai < 2; ++ai) {
            u32x4 xw[4][2];
#pragma unroll
            for (int m = 0; m < 4; ++m)
#pragma unroll
                for (int bj = 0; bj < 2; ++bj) xw[m][bj] = *(const u32x4*)(hbase + (size_t)(ai * 128 + m * 16) * DM + bj * 128);
#pragma unroll
            for (int m = 0; m < 4; ++m)
#pragma unroll
                for (int bj = 0; bj < 2; ++bj) { const size_t off = (size_t)(ai * 128 + m * 16) * DM + bj * 128;
                    const f32x4 a0 = acc[ai][bj][m][0], a1 = acc[ai][bj][m][1]; const u32x4 x4 = xw[m][bj];
                    u32x4 w; w.x = pkh2(hlo(x4.x) + a0[0], hhi(x4.x) + a0[1]); w.y = pkh2(hlo(x4.y) + a0[2], hhi(x4.y) + a0[3]);
                    w.z = pkh2(hlo(x4.z) + a1[0], hhi(x4.z) + a1[1]); w.w = pkh2(hlo(x4.w) + a1[2], hhi(x4.w) + a1[3]); *(u32x4*)(hbase + off) = w; }
            asm volatile("" ::: "memory");
        }
    }
};
struct EpiGate {
#ifndef GATE_PERM
#define GATE_PERM 1
#endif
    static constexpr bool PERM = (GATE_PERM != 0), AFTER_DRAIN = false, KPF = false;
    const bf16* ple; const bf16* xh; float* out;
    __device__ __forceinline__ void operator()(const f32x4 (&acc)[2][2][4][2], const pg8::Unit& u, int wr, int wc, int fr, int fq) const {
        if constexpr (PERM) {
        const int row0 = u.pm * 256 + wr * 64 + fr, col0 = u.pn * 256 + wc * 32 + 8 * fq;
        float* obase = out + (size_t)row0 * DM + col0; const bf16* hbase = xh + (size_t)row0 * DM + col0; const bf16* pbase = ple + (size_t)row0 * DM + col0;
#pragma unroll
        for (int ai = 0; ai < 2; ++ai) {
            u32x4 xw[4][2], pw[4][2];
#pragma unroll
            for (int m = 0; m < 4; ++m)
#pragma unroll
                for (int bj = 0; bj < 2; ++bj) { const size_t off = (size_t)(ai * 128 + m * 16) * DM + bj * 128; xw[m][bj] = *(const u32x4*)(hbase + off); pw[m][bj] = *(const u32x4*)(pbase + off); }
#pragma unroll
            for (int m = 0; m < 4; ++m)
#pragma unroll
                for (int bj = 0; bj < 2; ++bj) { const size_t off = (size_t)(ai * 128 + m * 16) * DM + bj * 128;
                    const f32x4 a0 = acc[ai][bj][m][0], a1 = acc[ai][bj][m][1]; const u32x4 p4 = pw[m][bj], x4 = xw[m][bj];
                    f32x4 o0, o1;
                    o0[0] = hlo(x4.x) + bflo(p4.x) * sigmoidf_(a0[0]); o0[1] = hhi(x4.x) + bfhi(p4.x) * sigmoidf_(a0[1]);
                    o0[2] = hlo(x4.y) + bflo(p4.y) * sigmoidf_(a0[2]); o0[3] = hhi(x4.y) + bfhi(p4.y) * sigmoidf_(a0[3]);
                    o1[0] = hlo(x4.z) + bflo(p4.z) * sigmoidf_(a1[0]); o1[1] = hhi(x4.z) + bfhi(p4.z) * sigmoidf_(a1[1]);
                    o1[2] = hlo(x4.w) + bflo(p4.w) * sigmoidf_(a1[2]); o1[3] = hhi(x4.w) + bfhi(p4.w) * sigmoidf_(a1[3]);
                    *(f32x4*)(obase + off) = o0; *(f32x4*)(obase + off + 4) = o1; }
            asm volatile("" ::: "memory");
        }
        } else {
        const int row0 = u.pm * 256 + wr * 64 + fr, col0 = u.pn * 256 + wc * 32 + 4 * fq;
        float* obase = out + (size_t)row0 * DM + col0; const bf16* hbase = xh + (size_t)row0 * DM + col0; const bf16* pbase = ple + (size_t)row0 * DM + col0;
#pragma unroll
        for (int ai = 0; ai < 2; ++ai) {
            u32x2 xw[4][2][2], pw[4][2][2];
#pragma unroll
            for (int m = 0; m < 4; ++m)
#pragma unroll
                for (int bj = 0; bj < 2; ++bj)
#pragma unroll
                    for (int n = 0; n < 2; ++n) { const size_t off = (size_t)(ai * 128 + m * 16) * DM + bj * 128 + n * 16; xw[m][bj][n] = *(const u32x2*)(hbase + off); pw[m][bj][n] = *(const u32x2*)(pbase + off); }
#pragma unroll
            for (int m = 0; m < 4; ++m)
#pragma unroll
                for (int bj = 0; bj < 2; ++bj)
#pragma unroll
                    for (int n = 0; n < 2; ++n) { const size_t off = (size_t)(ai * 128 + m * 16) * DM + bj * 128 + n * 16;
                        const f32x4 a0 = acc[ai][bj][m][n]; const u32x2 p2 = pw[m][bj][n], x2 = xw[m][bj][n];
                        f32x4 o0;
                        o0[0] = hlo(x2.x) + bflo(p2.x) * sigmoidf_(a0[0]); o0[1] = hhi(x2.x) + bfhi(p2.x) * sigmoidf_(a0[1]);
                        o0[2] = hlo(x2.y) + bflo(p2.y) * sigmoidf_(a0[2]); o0[3] = hhi(x2.y) + bfhi(p2.y) * sigmoidf_(a0[3]);
                        *(f32x4*)(obase + off) = o0; }
            asm volatile("" ::: "memory");
        }
        }
    }
};

template <bool F16 = false> __device__ __forceinline__ void transpose_item(const float* W, int K, int N, bf16* WT, int k0, int n0, int dst_row0, LAS float* scr, int lane, const float* kscale = nullptr) {
#pragma unroll 8
    for (int i = 0; i < 32; ++i) { const int kk = 2 * i + (lane >> 5); const float sc = kscale ? kscale[k0 + kk] : 1.0f; scr[kk * 33 + (lane & 31)] = W[(size_t)(k0 + kk) * N + n0 + (lane & 31)] * sc; }
    asm volatile("s_waitcnt lgkmcnt(0)" ::: "memory");
    const int c = lane & 7;
#pragma unroll
    for (int j = 0; j < 4; ++j) { const int n = (lane >> 3) + 8 * j; const LAS float* s = scr + (8 * c) * 33 + n;
        u32x4 o;
        if constexpr (F16) { o.x = pkh2(s[0 * 33], s[1 * 33]); o.y = pkh2(s[2 * 33], s[3 * 33]); o.z = pkh2(s[4 * 33], s[5 * 33]); o.w = pkh2(s[6 * 33], s[7 * 33]); }
        else { o.x = pk2(s[0 * 33], s[1 * 33]); o.y = pk2(s[2 * 33], s[3 * 33]); o.z = pk2(s[4 * 33], s[5 * 33]); o.w = pk2(s[6 * 33], s[7 * 33]); }
        *(u32x4*)(WT + (size_t)(dst_row0 + n) * K + k0 + 8 * c) = o; }
    asm volatile("s_waitcnt lgkmcnt(0)" ::: "memory");
}
__device__ __forceinline__ float wave_sum(float v) {
#pragma unroll
    for (int o = 1; o < 64; o <<= 1) v += __shfl_xor(v, o);
    return v;
}

struct Params {
    const float* xp; const float* xs; const float* pp; const float* ps; const float* norm_w; const float* w_in;
    const float* qna; const float* kna; const float* sink; const float* qnb; const float* knb; const float* rpb;
    const float* w_out; const float* w_ple; const float* w_gate; float* out; unsigned char* ws;
    int ph_lo, ph_hi;
};

__device__ __forceinline__ void prologue(const Params& a, LAS unsigned char* lds, int tid, int lane, int wave, int G) {
    LAS float* scr = (LAS float*)(lds + wave * 16384);
    const int gw = blockIdx.x * NWAVES + wave, NGW = G * NWAVES;
    bf16* win_t = (bf16*)(a.ws + WS_WIN); bf16* wout_t = (bf16*)(a.ws + WS_WOUT); bf16* wgate_t = (bf16*)(a.ws + WS_WGATE); bf16* wple_t = (bf16*)(a.ws + WS_WPLE);
    constexpr int I_IN = (DM / 64) * (NIN / 32), I_SQ = (DM / 64) * (DM / 32), I_PLE = (PLE / 64) * (DM / 32);
    constexpr int NITEMS = I_IN + 2 * I_SQ + I_PLE;
    for (int it = gw; it < NITEMS; it += NGW) {
        int r = it;
        if (r < I_IN) { const int nblk = NIN / 32, kb = r / nblk, nb = r % nblk; const int n0 = 32 * nb; const int ga = (n0 & 255) >> 5, gl = 4 * (ga & 1) + (ga >> 1);
            transpose_item<true>(a.w_in, DM, NIN, win_t, 64 * kb, n0, (n0 & ~255) + 32 * gl, scr, lane, a.norm_w); continue; }
        r -= I_IN;
        if (r < I_SQ) { const int kb = r / 32, nb = r % 32; transpose_item(a.w_out, DM, DM, wout_t, 64 * kb, 32 * nb, 32 * nb, scr, lane); continue; }
        r -= I_SQ;
        if (r < I_SQ) { const int kb = r / 32, nb = r % 32; transpose_item<true>(a.w_gate, DM, DM, wgate_t, 64 * kb, 32 * nb, 32 * nb, scr, lane); continue; }
        r -= I_SQ;
        { const int kb = r / 32, nb = r % 32; transpose_item(a.w_ple, PLE, DM, wple_t, 64 * kb, 32 * nb, 32 * nb, scr, lane); }
    }
    {
        float* rope = (float*)(a.ws + WS_ROPE);
        const double inv_freq[8] = {1.0, 0.19392274474868576, 0.03760603093086393, 0.007292664737217109, 0.001414213562373095, 0.0002742481756762073, 5.318295896944988e-05, 1.031338537721246e-05};
        for (int e = blockIdx.x * NTHREADS + tid; e < SEQ * 8; e += G * NTHREADS) {
            const int pos = e >> 3, i = e & 7;
            double f = 1.0;
#pragma unroll
            for (int k = 0; k < 8; ++k) f = (i == k) ? inv_freq[k] : f;
            double t = (double)pos * f * 0.15915494309189535; t -= __builtin_floor(t);
            const float tf = (float)t;
            rope[pos * 16 + i] = __builtin_amdgcn_cosf(tf); rope[pos * 16 + 8 + i] = __builtin_amdgcn_sinf(tf);
        }
    }
    {
        bf16* xh = (bf16*)(a.ws + WS_XN); float* rinv = (float*)(a.ws + WS_RINV);
        for (int m0 = gw; m0 < MTOK; m0 += 2 * NGW) {
            f32x4 v[2][4];
#pragma unroll
            for (int r = 0; r < 2; ++r) { const int m = m0 + r * NGW;
                if (m < MTOK) { const float* xrow = (m < MPROMPT) ? a.xp + (size_t)m * DM : a.xs + (size_t)(m - MPROMPT) * DM; const f32x4* xr = (const f32x4*)xrow + lane;
#pragma unroll
                    for (int j = 0; j < 4; ++j) v[r][j] = xr[64 * j]; } }
#pragma unroll
            for (int r = 0; r < 2; ++r) { const int m = m0 + r * NGW;
                if (m < MTOK) { float ss = 0.f;
#pragma unroll
                    for (int j = 0; j < 4; ++j) ss += (v[r][j][0] * v[r][j][0] + v[r][j][1] * v[r][j][1]) + (v[r][j][2] * v[r][j][2] + v[r][j][3] * v[r][j][3]);
                    ss = wave_sum(ss);
                    if (lane == 0) rinv[m] = 1.0f / sqrtf(ss * (1.0f / DM) + EPS);
                    u32x2* o8 = (u32x2*)(xh + (size_t)m * DM) + lane;
#pragma unroll
                    for (int j = 0; j < 4; ++j) { u32x2 w2; w2.x = pkh2(v[r][j][0], v[r][j][1]); w2.y = pkh2(v[r][j][2], v[r][j][3]); o8[64 * j] = w2; } } }
        }
    }
    {
        bf16* pbf = (bf16*)(a.ws + WS_PBF);
        const size_t n4 = (size_t)MTOK * PLE / 4, np4 = (size_t)MPROMPT * PLE / 4;
        for (size_t e = (size_t)blockIdx.x * NTHREADS + tid; e < n4; e += (size_t)G * NTHREADS) {
            const f32x4 v = (e < np4) ? ((const f32x4*)a.pp)[e] : ((const f32x4*)a.ps)[e - np4];
            u32x2 w2; w2.x = pk2(v[0], v[1]); w2.y = pk2(v[2], v[3]); ((u32x2*)pbf)[e] = w2;
        }
    }
}

constexpr int KP = 144, VP = 160;
typedef short v4i16_t __attribute__((ext_vector_type(4)));
__device__ __forceinline__ s16x4 tr_read(const LAS unsigned char* p) { return __builtin_bit_cast(s16x4, __builtin_amdgcn_ds_read_tr16_b64_v4i16((LAS v4i16_t*)p)); }
__device__ __forceinline__ f32x4 mfma16(bf16x8 a, bf16x8 b, f32x4 c) { return __builtin_amdgcn_mfma_f32_16x16x32_bf16(a, b, c, 0, 0, 0); }

template <int NT> __device__ __forceinline__ void softmax_pv_store(float (&S)[NT][4], float sink_term_valid, float sinkv, const LAS unsigned char* Vs, int vrow0,
                                                                   const u32x2 (&gatev)[4], bf16* out_ptr, int i16, int g) {
    float m = sink_term_valid != 0.f ? sinkv : -INFINITY;
#pragma unroll
    for (int t = 0; t < NT; ++t)
#pragma unroll
        for (int r = 0; r < 4; ++r) m = fmaxf(m, S[t][r]);
    m = fmaxf(m, __shfl_xor(m, 16)); m = fmaxf(m, __shfl_xor(m, 32));
    const float mb = m * L2E;
#pragma unroll
    for (int t = 0; t < NT; ++t)
#pragma unroll
        for (int r = 0; r < 4; ++r) S[t][r] = fast_exp2(S[t][r] * L2E - mb);
    f32x4 lsum = (f32x4){0.f, 0.f, 0.f, 0.f};
    const bf16x8 ones = (bf16x8){0x3f80, 0x3f80, 0x3f80, 0x3f80, 0x3f80, 0x3f80, 0x3f80, 0x3f80};
    f32x4 o[4];
#pragma unroll
    for (int dt = 0; dt < 4; ++dt) o[dt] = (f32x4){0.f, 0.f, 0.f, 0.f};
    const LAS unsigned char* vb = Vs + (vrow0 + 4 * g + (i16 >> 2)) * VP + (i16 & 3) * 8;
    constexpr int NS = (NT + 1) / 2;
#pragma unroll
    for (int s = 0; s < NS; ++s) {
        u32x4 pw; pw.x = pk2(S[2 * s][0], S[2 * s][1]); pw.y = pk2(S[2 * s][2], S[2 * s][3]);
        if (2 * s + 1 < NT) { pw.z = pk2(S[(2 * s + 1) < NT ? 2 * s + 1 : 0][0], S[(2 * s + 1) < NT ? 2 * s + 1 : 0][1]); pw.w = pk2(S[(2 * s + 1) < NT ? 2 * s + 1 : 0][2], S[(2 * s + 1) < NT ? 2 * s + 1 : 0][3]); }
        else { pw.z = 0u; pw.w = 0u; }
        const bf16x8 pf = __builtin_bit_cast(bf16x8, pw);
#pragma unroll
        for (int dt = 0; dt < 4; ++dt) {
            const s16x4 lo = tr_read(vb + (32 * s) * VP + dt * 32), hi = tr_read(vb + (32 * s + 16) * VP + dt * 32);
            const bf16x8 vf = (bf16x8){lo[0], lo[1], lo[2], lo[3], hi[0], hi[1], hi[2], hi[3]};
            o[dt] = mfma16(vf, pf, o[dt]);
        }
        lsum = mfma16(ones, pf, lsum);
    }
    float l = lsum[0];
    if (sink_term_valid != 0.f) l += fast_exp2(sinkv * L2E - mb);
    const float inv = 1.0f / l;
#pragma unroll
    for (int dt = 0; dt < 4; ++dt) {
        const u32x2 gw = gatev[dt];
        u32x2 w2; w2.x = pk2(o[dt][0] * inv * bflo(gw.x), o[dt][1] * inv * bfhi(gw.x)); w2.y = pk2(o[dt][2] * inv * bflo(gw.y), o[dt][3] * inv * bfhi(gw.y));
        *(u32x2*)(out_ptr + dt * 16 + 4 * g) = w2;
    }
}

struct PfA { u32x4 k[7], v[7]; };
__device__ __forceinline__ void attnA_fetch(PfA& pf, const bf16* KA, const bf16* VA, int u, int tid) {
    const int kh = u & 1, j = (u >> 1) & 15, b = u >> 5, span0 = j * 128 - 128;
#pragma unroll
    for (int i = 0; i < 7; ++i) {
        const int c = tid + NTHREADS * i, row = c >> 3, ch = c & 7, kpos = span0 + row;
        pf.k[i] = (u32x4){0u, 0u, 0u, 0u}; pf.v[i] = (u32x4){0u, 0u, 0u, 0u};
        if (row < 384 && kpos >= 0 && kpos < SEQ) { const size_t o = ((size_t)(b * 2 + kh) * SEQ + kpos) * 64 + ch * 8; pf.k[i] = *(const u32x4*)(KA + o); pf.v[i] = *(const u32x4*)(VA + o); }
    }
}
__device__ __forceinline__ void attnA_commit(const PfA& pf, LAS unsigned char* lds, int tid) {
    LAS unsigned char* Ks = lds; LAS unsigned char* Vs = lds + 384 * KP;
#pragma unroll
    for (int i = 0; i < 7; ++i) {
        const int c = tid + NTHREADS * i, row = c >> 3, ch = c & 7;
        if (row < 384) *(LAS u32x4*)(Ks + row * KP + ch * 16) = pf.k[i];
        if (row < 400) *(LAS u32x4*)(Vs + row * VP + ch * 16) = pf.v[i];
    }
}
__device__ __forceinline__ void attnA_compute(LAS unsigned char* lds, const bf16* proj, bf16* mix, const float* sink, int u, int lane, int wave) {
    const int kh = u & 1, j = (u >> 1) & 15, b = u >> 5;
    const LAS unsigned char* Ks = lds; const LAS unsigned char* Vs = lds + 384 * KP;
    const int i16 = lane & 15, g = lane >> 4;
    const int head = kh * 4 + (wave >> 1);
    const float sinkv = sink[head];
    bf16x8 qf[4][2];
#pragma unroll
    for (int i = 0; i < 4; ++i) { const int qt = (wave & 1) * 4 + i; const size_t tokq = (size_t)b * SEQ + j * 128 + qt * 16 + i16;
        const bf16* qp = proj + tokq * NPJ + C_QA + head * 64 + g * 8; qf[i][0] = *(const bf16x8*)(qp); qf[i][1] = *(const bf16x8*)(qp + 32); }
#pragma unroll
    for (int i = 0; i < 4; ++i) {
        const int qt = (wave & 1) * 4 + i, q0 = j * 128 + qt * 16;
        const size_t tokq = (size_t)b * SEQ + q0 + i16;
        u32x2 gatev[4];
#pragma unroll
        for (int dt = 0; dt < 4; ++dt) gatev[dt] = *(const u32x2*)(proj + tokq * NPJ + C_GA + head * 64 + dt * 16 + 4 * g);
        const bf16x8 qf0 = qf[i][0], qf1 = qf[i][1];
        float S[17][4];
        const LAS unsigned char* kb = Ks + (qt * 16 + i16) * KP + g * 16;
#pragma unroll
        for (int t = 0; t < 17; ++t) {
            const int kpos0 = q0 - 128 + 16 * t;
            if (kpos0 >= 0 && kpos0 < SEQ) {
                f32x4 acc = (f32x4){0.f, 0.f, 0.f, 0.f};
                acc = mfma16(*(const LAS bf16x8*)(kb + 16 * t * KP), qf0, acc);
                acc = mfma16(*(const LAS bf16x8*)(kb + 16 * t * KP + 64), qf1, acc);
#pragma unroll
                for (int r = 0; r < 4; ++r) S[t][r] = acc[r];
            } else {
#pragma unroll
                for (int r = 0; r < 4; ++r) S[t][r] = -INFINITY;
            }
        }
#pragma unroll
        for (int r = 0; r < 4; ++r) { if (4 * g + r < i16) S[0][r] = -INFINITY; if (4 * g + r > i16) S[16][r] = -INFINITY; }
        softmax_pv_store<17>(S, 1.f, sinkv, Vs, qt * 16, gatev, mix + tokq * DM + head * 64, i16, g);
    }
}

__device__ __forceinline__ int clampi(int v, int lo, int hi) { return v < lo ? lo : (v > hi ? hi : v); }
constexpr int B_KROWS = 480, B_VOFF = B_KROWS * KP, B_TOFF = B_VOFF + B_KROWS * VP;
static_assert(B_TOFF + 2048 <= LDS_BYTES - 64 && 384 * KP + 400 * VP <= LDS_BYTES, "LDS map");
struct PfB { u32x4 k[8], v[8]; float bias; bf16x8 q0, q1; u32x2 gate[4]; };
__device__ __forceinline__ void attnB_fetch(PfB& pf, const bf16* proj, const bf16* KB, const bf16* VB, const float* rpb, int v, int tid) {
    const int R = v & 3, n = (v >> 2) & 3, h = (v >> 4) & 7, b = v >> 7;
    const int krow0 = clampi(8 * R - 4, 0, 24), krow1 = clampi(8 * R + 3, 0, 24) + 7, nrows = krow1 - krow0 + 1;
    const int blk = clampi(16 * n - 8, 0, 32);
#pragma unroll
    for (int i = 0; i < 8; ++i) {
        const int c = tid + NTHREADS * i, row = c >> 3, ch = c & 7; const int krow = krow0 + (row >> 5), kc = blk + (row & 31);
        pf.k[i] = (u32x4){0u, 0u, 0u, 0u}; pf.v[i] = (u32x4){0u, 0u, 0u, 0u};
        if (row < nrows * 32) { const size_t o = ((size_t)(b * 8 + h) * SEQ + krow * 64 + kc) * 64 + ch * 8; pf.k[i] = *(const u32x4*)(KB + o); pf.v[i] = *(const u32x4*)(VB + o); }
    }
    { const int idx = tid - 16; pf.bias = (idx >= 0 && idx < 465) ? rpb[h * 465 + idx] : 0.f; }
    { const int lane = tid & 63, wave = tid >> 6; const size_t tokq = (size_t)b * SEQ + (8 * R + wave) * 64 + 16 * n + (lane & 15);
      const bf16* qp = proj + tokq * NPJ + C_QB + h * 64 + (lane >> 4) * 8; pf.q0 = *(const bf16x8*)(qp); pf.q1 = *(const bf16x8*)(qp + 32);
#pragma unroll
      for (int dt = 0; dt < 4; ++dt) pf.gate[dt] = *(const u32x2*)(proj + tokq * NPJ + C_GB + h * 64 + dt * 16 + 4 * (lane >> 4)); }
}
__device__ __forceinline__ void attnB_commit(const PfB& pf, LAS unsigned char* lds, int tid) {
    LAS unsigned char* Ks = lds; LAS unsigned char* Vs = lds + B_VOFF; LAS float* tbl = (LAS float*)(lds + B_TOFF);
#pragma unroll
    for (int i = 0; i < 8; ++i) {
        const int c = tid + NTHREADS * i, row = c >> 3, ch = c & 7;
        if (row < B_KROWS) { *(LAS u32x4*)(Ks + row * KP + ch * 16) = pf.k[i]; *(LAS u32x4*)(Vs + row * VP + ch * 16) = pf.v[i]; }
    }
    tbl[tid] = pf.bias;
}
__device__ __forceinline__ void attnB_compute(LAS unsigned char* lds, bf16* mix, int v, bf16x8 qf0, bf16x8 qf1, const u32x2 (&gatev)[4], int lane, int wave) {
    const int R = v & 3, n = (v >> 2) & 3, h = (v >> 4) & 7, b = v >> 7;
    const LAS unsigned char* Ks = lds; const LAS unsigned char* Vs = lds + B_VOFF; const LAS float* tbl = (const LAS float*)(lds + B_TOFF);
    const int krow0 = clampi(8 * R - 4, 0, 24);
    const int blk = clampi(16 * n - 8, 0, 32);
    const int i16 = lane & 15, g = lane >> 4;
    const int r = 8 * R + wave, rs = clampi(r - 4, 0, 24), c = 16 * n + i16, cs = clampi(c - 8, 0, 48);
    const size_t tokq = (size_t)b * SEQ + r * 64 + c;
    const int lrow0 = (rs - krow0) * 32;
    float S[16][4];
    const LAS unsigned char* kb = Ks + (lrow0 + i16) * KP + g * 16;
    const LAS float* tb = tbl + 16 + (rs - r + 7) * 31 + (blk + 4 * g - c + 15);
    const int kc0 = blk + 4 * g;
#pragma unroll
    for (int t = 0; t < 16; ++t) {
        const int a = t >> 1, ch = t & 1;
        f32x4 acc = (f32x4){tb[a * 31 + 16 * ch + 0], tb[a * 31 + 16 * ch + 1], tb[a * 31 + 16 * ch + 2], tb[a * 31 + 16 * ch + 3]};
        acc = mfma16(*(const LAS bf16x8*)(kb + (32 * a + 16 * ch) * KP), qf0, acc);
        acc = mfma16(*(const LAS bf16x8*)(kb + (32 * a + 16 * ch) * KP + 64), qf1, acc);
#pragma unroll
        for (int rr = 0; rr < 4; ++rr) { const int kc = kc0 + 16 * ch + rr; const bool valid = (kc >= cs) && (kc < cs + 16);
            S[t][rr] = valid ? acc[rr] : -INFINITY; }
    }
    softmax_pv_store<16>(S, 0.f, 0.f, Vs, lrow0, gatev, mix + tokq * DM + 512 + h * 64, i16, g);
}
__device__ __forceinline__ const bf16* attnB_qptr(const bf16* proj, int v, int lane, int wave) {
    const int R = v & 3, n = (v >> 2) & 3, h = (v >> 4) & 7, b = v >> 7;
    const size_t tokq = (size_t)b * SEQ + (8 * R + wave) * 64 + 16 * n + (lane & 15);
    return proj + tokq * NPJ + C_QB + h * 64 + (lane >> 4) * 8;
}
__device__ __forceinline__ void attention_phase(LAS unsigned char* lds, const bf16* proj, const bf16* KA, const bf16* VA, const bf16* KB, const bf16* VB, bf16* mix, const float* sink, const float* rpb, int G, int tid, int lane, int wave) {
    constexpr int NA = NBATCH * 16 * 2, NBU = NBATCH * 8 * 4 * 4;
#ifndef REPA
#define REPA 1
#endif
#ifndef REPB
#define REPB 1
#endif
    for (int repa = 0; repa < REPA; ++repa) {
        int u = blockIdx.x; PfA pf;
        if (u < NA) attnA_fetch(pf, KA, VA, u, tid);
        for (; u < NA; u += G) {
            attnA_commit(pf, lds, tid);
            __syncthreads();
            if (u + G < NA) attnA_fetch(pf, KA, VA, u + G, tid);
            attnA_compute(lds, proj, mix, sink, u, lane, wave);
            __syncthreads();
        }
    }
    for (int repb = 0; repb < REPB; ++repb) {
        int v = blockIdx.x; PfB pf;
        if (v < NBU) attnB_fetch(pf, proj, KB, VB, rpb, v, tid);
        for (; v < NBU; v += G) {
            attnB_commit(pf, lds, tid);
            const bf16x8 qf0 = pf.q0, qf1 = pf.q1; u32x2 gatev[4];
#pragma unroll
            for (int dt = 0; dt < 4; ++dt) gatev[dt] = pf.gate[dt];
            __syncthreads();
            if (v + G < NBU) attnB_fetch(pf, proj, KB, VB, rpb, v + G, tid);
#ifndef REPBC
#define REPBC 1
#endif
            for (int rc = 0; rc < REPBC; ++rc) { attnB_compute(lds, mix, v, qf0, qf1, gatev, lane, wave); asm volatile("" ::: "memory"); }
            __syncthreads();
        }
    }
}

#define XB_TMO      128
#define XB_XCNT(j)  (256  + 64 * (j))
#define XB_XSUB(j)  (1280 + 64 * (j))
#define XB_XGEN(j)  (2304 + 64 * (j))
#define XB_TOP      3328
#define XB_TOPGEN   3392
#define XCD_BAR_WORDS 3456
#define XB_SPIN_CAP (1u << 18)

__device__ __forceinline__ unsigned xb_ld(unsigned* p)              { return __hip_atomic_load(p, __ATOMIC_RELAXED, __HIP_MEMORY_SCOPE_AGENT); }
__device__ __forceinline__ unsigned xb_add(unsigned* p, unsigned v) { return __hip_atomic_fetch_add(p, v, __ATOMIC_RELAXED, __HIP_MEMORY_SCOPE_AGENT); }
__device__ __forceinline__ unsigned xb_xcc_id() { return (unsigned)__builtin_amdgcn_s_getreg((3 << 11) | 20) & 0xFu; }
#define XB_SPIN(cond, bar) do { unsigned _sp = 0; while (cond) { __builtin_amdgcn_s_sleep(1); \
    if ((++_sp & 255u) == 0u) { if (xb_ld(&(bar)[XB_TMO])) break; if (_sp > XB_SPIN_CAP) { atomicAdd(&(bar)[XB_TMO], 1u); break; } } } } while (0)

struct XcdBarrier {
    unsigned* bar; unsigned x;
    volatile LAS unsigned* st;
};

__device__ __forceinline__ XcdBarrier xcd_barrier_post(unsigned* bar, volatile LAS unsigned* st) {
    XcdBarrier b; b.bar = bar; b.x = xb_xcc_id(); b.st = st;
    if (threadIdx.x == 0) (void)xb_add(&bar[XB_XCNT(b.x)], 1u);
    return b;
}
__device__ __forceinline__ void xcd_barrier_complete(unsigned* bar, unsigned x, unsigned& nloc, unsigned& nx) {
    const unsigned G = gridDim.x * gridDim.y * gridDim.z;
    unsigned sum, cnt, mine, sp = 0u;
    for (;;) {
        sum = 0u; cnt = 0u; mine = 0u;
#pragma unroll
        for (unsigned j = 0; j < 16; ++j) { const unsigned c = xb_ld(&bar[XB_XCNT(j)]); sum += c; cnt += (c > 0u) ? 1u : 0u; mine = (j == x) ? c : mine; }
        if (sum == G) break;
        __builtin_amdgcn_s_sleep(1);
        if ((++sp & 255u) == 0u) { if (xb_ld(&bar[XB_TMO])) break; if (sp > XB_SPIN_CAP) { atomicAdd(&bar[XB_TMO], 1u); break; } }
    }
    nloc = mine > 0u ? mine : 1u; nx = cnt > 0u ? cnt : 1u;
}

__device__ __forceinline__ void xcd_barrier(const XcdBarrier& b) {
    asm volatile("s_waitcnt vmcnt(0)" ::: "memory");
    __syncthreads();
    if (threadIdx.x == 0) {
        unsigned* bar = b.bar;
        __builtin_amdgcn_s_waitcnt(0);
        unsigned nloc = b.st[0], nx = b.st[1];
        if (nloc == 0u) { xcd_barrier_complete(bar, b.x, nloc, nx); b.st[0] = nloc; b.st[1] = nx; }
        const unsigned old = xb_add(&bar[XB_XSUB(b.x)], 1u);
        const unsigned gen = old / nloc;
        if (old + 1u == (gen + 1u) * nloc) {
            __builtin_amdgcn_fence(__ATOMIC_RELEASE, "agent");
            asm volatile("s_waitcnt vmcnt(0)" ::: "memory");
            const unsigned og = xb_add(&bar[XB_TOP], 1u);
            const unsigned tg = og / nx;
            if (og + 1u == (tg + 1u) * nx) xb_add(&bar[XB_TOPGEN], 1u);
            else XB_SPIN(xb_ld(&bar[XB_TOPGEN]) == tg, bar);
            __builtin_amdgcn_fence(__ATOMIC_ACQUIRE, "agent");
            xb_add(&bar[XB_XGEN(b.x)], 1u);
            asm volatile("s_waitcnt vmcnt(0)" ::: "memory");
        } else {
            XB_SPIN(xb_ld(&bar[XB_XGEN(b.x)]) == gen, bar);
            __builtin_amdgcn_fence(__ATOMIC_ACQUIRE, "agent");
            asm volatile("s_waitcnt vmcnt(0)" ::: "memory");
        }
    }
    __syncthreads();
}

__global__ void __launch_bounds__(NTHREADS, 2) enc_fwd(Params a) {
    extern __shared__ __attribute__((aligned(16))) unsigned char lds_raw[];
    LAS unsigned char* lds = (LAS unsigned char*)lds_raw;
    const int tid = threadIdx.x, lane = tid & 63, wave = __builtin_amdgcn_readfirstlane(tid >> 6);
    const int G = gridDim.x;
    cg::grid_group grid = cg::this_grid();
    volatile LAS unsigned* misc = (volatile LAS unsigned*)(lds + LDS_BYTES - 64);
    if (tid < 16) misc[tid] = 0u;
    __syncthreads();
    XcdBarrier xbar = xcd_barrier_post((unsigned*)(a.ws + WS_CTL), misc);
    if (a.ph_lo > 1000) grid.sync();
    unsigned char* ws = a.ws;
    bf16* xn = (bf16*)(ws + WS_XN); bf16* pbf = (bf16*)(ws + WS_PBF); bf16* proj = (bf16*)(ws + WS_PROJ); bf16* mix = (bf16*)(ws + WS_MIX); bf16* ple = (bf16*)(ws + WS_KB); float* x2f = (float*)(ws + WS_PROJ);
    const int lo = a.ph_lo, hi = a.ph_hi;
#ifdef PHASE_MASK
#define IN(k) (((PHASE_MASK >> (k)) & 1) && lo <= (k) && (k) < hi)
#else
#define IN(k) (lo <= (k) && (k) < hi)
#endif
#define SEAM(k) do { if (IN(k) && IN((k) + 1)) xcd_barrier(xbar); } while (0)
#ifndef GREP1
#define GREP1 1
#endif
#ifndef GREP3
#define GREP3 1
#endif
#ifndef GREP3B
#define GREP3B 1
#endif
#ifndef GREP4
#define GREP4 1
#endif
#ifndef REP0
#define REP0 1
#endif
#ifndef REP1
#define REP1 1
#endif
#ifndef REP2
#define REP2 1
#endif
#ifndef REP3
#define REP3 1
#endif
    if (IN(0)) for (int rep = 0; rep < REP0; ++rep) prologue(a, lds, tid, lane, wave, G);
    SEAM(0);
#ifdef XSYNC
    for (int q = 0; q < XSYNC; ++q) xcd_barrier(xbar);
#endif
    if (IN(1)) for (int rep = 0; rep < REP1; ++rep) {
        pg8::Gemm g{xn, (const bf16*)(ws + WS_WIN), MTOK, NIN, DM}; pg8::StaticOrder S; S.init(MTOK, NIN, G, (int)blockIdx.x); S.reps = GREP1;
        EpiProj E{proj, (bf16*)(ws + WS_KA), (bf16*)(ws + WS_VA), (bf16*)(ws + WS_KB), (bf16*)(ws + WS_VB), (const float*)(ws + WS_RINV), a.qna, a.kna, a.qnb, a.knb, (const float*)(ws + WS_ROPE)};
        pg8::gemm_phase<EpiProj, pg8::StaticOrder, true, true, true>(lds, g, S, E);
    }
    SEAM(1);
    if (IN(2)) for (int rep = 0; rep < REP2; ++rep) attention_phase(lds, proj, (const bf16*)(ws + WS_KA), (const bf16*)(ws + WS_VA), (const bf16*)(ws + WS_KB), (const bf16*)(ws + WS_VB), mix, a.sink, a.rpb, G, tid, lane, wave);
    SEAM(2);
    if (IN(3)) {
#ifndef STAGGER3
#define STAGGER3 0
#endif
        const int kst = STAGGER3 ? (((blockIdx.x >> 3) & 1) ? STAGGER3 : 0) : 0;
        pg8::Gemm gp{pbf, (const bf16*)(ws + WS_WPLE), MTOK, DM, PLE}; EpiPlain Ep{ple, DM};
        if (kst > 0) { pg8::StaticOrder S; S.init(MTOK, DM, G, (int)blockIdx.x); S.reps = GREP3B; S.i0 = 0; S.i1 = kst;
          pg8::gemm_phase<EpiPlain, pg8::StaticOrder, true, true>(lds, gp, S, Ep); }
        { pg8::Gemm g{mix, (const bf16*)(ws + WS_WOUT), MTOK, DM, DM}; pg8::StaticOrder S; S.init(MTOK, DM, G, (int)blockIdx.x); S.reps = GREP3;
          EpiRes E{xn};
          pg8::gemm_phase<EpiRes, pg8::StaticOrder, true, true>(lds, g, S, E); }
        { pg8::StaticOrder S; S.init(MTOK, DM, G, (int)blockIdx.x); S.reps = GREP3B; S.i0 = kst;
          pg8::gemm_phase<EpiPlain, pg8::StaticOrder, true, true>(lds, gp, S, Ep); }
    }
    SEAM(3);
    if (IN(4)) {
        pg8::Gemm g{xn, (const bf16*)(ws + WS_WGATE), MTOK, DM, DM}; pg8::StaticOrder S; S.init(MTOK, DM, G, (int)blockIdx.x); S.reps = GREP4;
        EpiGate E{ple, xn, a.out};
        pg8::gemm_phase<EpiGate, pg8::StaticOrder, true, true, true>(lds, g, S, E);
    }
#undef IN
#undef SEAM
}

#ifndef N_LAUNCHES
#define N_LAUNCHES 1
#endif
extern "C" void kernel_launch(void* const* d_in, const int* in_sizes, int n_in, void* d_out, int out_size, void* d_ws, size_t ws_size, hipStream_t stream) {
    static int grid = 0;
    if (grid == 0) {
        if (ws_size < WS_END) { fprintf(stderr, "kernel_launch: workspace too small (%zu < %zu)\n", ws_size, (size_t)WS_END); grid = -1; return; }
        int dev = 0, cus = 0, per_cu = 0;
        hipGetDevice(&dev);
        hipDeviceGetAttribute(&cus, hipDeviceAttributeMultiprocessorCount, dev);
        hipFuncSetAttribute((const void*)enc_fwd, hipFuncAttributeMaxDynamicSharedMemorySize, LDS_BYTES);
        hipOccupancyMaxActiveBlocksPerMultiprocessor(&per_cu, (const void*)enc_fwd, NTHREADS, LDS_BYTES);
        if (per_cu < 1) { fprintf(stderr, "kernel_launch: occupancy query says %d blocks per CU\n", per_cu); per_cu = 1; }
        grid = cus * 1;
        (void)hipGetLastError();
    }
    if (grid < 0) return;
    Params p{};
    p.xp = (const float*)d_in[0]; p.xs = (const float*)d_in[1]; p.pp = (const float*)d_in[2]; p.ps = (const float*)d_in[3];
    p.norm_w = (const float*)d_in[4]; p.w_in = (const float*)d_in[5]; p.qna = (const float*)d_in[6]; p.kna = (const float*)d_in[7]; p.sink = (const float*)d_in[8];
    p.qnb = (const float*)d_in[9]; p.knb = (const float*)d_in[10]; p.rpb = (const float*)d_in[11]; p.w_out = (const float*)d_in[12]; p.w_ple = (const float*)d_in[13]; p.w_gate = (const float*)d_in[14];
    p.out = (float*)d_out; p.ws = (unsigned char*)d_ws;
    hipMemsetAsync((char*)d_ws + WS_CTL, 0, CTL_BYTES, stream);
#if N_LAUNCHES == 1
    p.ph_lo = 0; p.ph_hi = 5;
    void* args[] = {&p};
    hipError_t e = hipLaunchCooperativeKernel((const void*)enc_fwd, dim3(grid), dim3(NTHREADS), args, LDS_BYTES, stream);
    if (e != hipSuccess) fprintf(stderr, "cooperative launch failed: %s (grid %d)\n", hipGetErrorString(e), grid);
#else
    for (int ph = 0; ph < 5; ++ph) { p.ph_lo = ph; p.ph_hi = ph + 1; hipLaunchKernelGGL(enc_fwd, dim3(grid), dim3(NTHREADS), LDS_BYTES, stream, p); }
#endif
}
```

```cpp
#include <hip/hip_runtime.h>
#include <hip/hip_cooperative_groups.h>
#include <cstdio>
#include <cstdint>
#include <cmath>
namespace cg = cooperative_groups;
namespace pg8 {
#define PG8_LAS __attribute__((address_space(3)))
typedef unsigned short bf16_t;
typedef short bf16x8 __attribute__((ext_vector_type(8)));
typedef float f32x4 __attribute__((ext_vector_type(4)));
typedef unsigned u32x4 __attribute__((ext_vector_type(4)));
constexpr int BM = 256, BK = 64, HALF = 128, HTB = HALF * BK * 2  , STAGE_BYTES = 8 * HTB, NXCD = 8, WGM = 8;

__host__ __device__ __forceinline__ int lds_byte(int r, int c) { const int st = (r >> 4) * 2 + (c >> 5), rr = r & 15, cc = c & 31, ob = rr * 64 + cc * 2; return st * 1024 + (ob ^ (((ob >> 9) & 1) << 5)); }
__host__ __device__ __forceinline__ void stage_rc(int b, int& R, int& C) { const int st = b / 1024, sb = b % 1024, swz = sb ^ (((sb >> 9) & 1) << 5); R = (st >> 1) * 16 + swz / 64; C = (st & 1) * 32 + (swz % 64) / 2; }
__host__ __device__ __forceinline__ int perm32(int rho) { const int n = rho >> 4, i = rho & 15; return 8 * (i >> 2) + 4 * n + (i & 3); }

struct Unit { int pm, pn; };
struct Gemm { const bf16_t* A; const bf16_t* Bt; int M, N, K; };

struct StaticOrder {
    int nM, nN, nwg, G, c, reps = 1, i0 = 0, i1 = 1 << 30;
    __host__ __device__ void init(int M, int N, int G_, int c_) { nM = M / BM; nN = N / BM; nwg = nM * nN; G = G_; c = c_; }
    __host__ __device__ bool next(int ii, Unit& u) const {
        const int i = ii + i0; if (i >= i1) return false;
        const long L = (long)i * G + c; if (L >= (long)nwg * reps) return false;
        int wgid = (int)(L % nwg); { const int q = nwg / NXCD, r = nwg % NXCD, xcd = wgid % NXCD, off = wgid / NXCD; wgid = (xcd < r ? xcd * (q + 1) : r * (q + 1) + (xcd - r) * q) + off; }
        const int nig = WGM * nN, gid = wgid / nig, fm = gid * WGM, gsz = (nM - fm) < WGM ? (nM - fm) : WGM;
        u.pm = fm + ((wgid % nig) % gsz); u.pn = (wgid % nig) / gsz; return true;
    }
    __device__ __forceinline__ void a_ready(const Unit&) const {}
    __device__ __forceinline__ void done(const Unit&) const {}
};

__device__ __forceinline__ unsigned cvt_pk_bf16(float lo, float hi) { unsigned r; asm volatile("v_cvt_pk_bf16_f32 %0, %1, %2" : "=v"(r) : "v"(lo), "v"(hi)); return r; }
typedef float f32x2 __attribute__((ext_vector_type(2)));
template <bool F16> __device__ __forceinline__ f32x4 mma16(bf16x8 a, bf16x8 b, f32x4 c) {
    if constexpr (F16) { typedef _Float16 h8 __attribute__((ext_vector_type(8))); return __builtin_amdgcn_mfma_f32_16x16x32_f16(__builtin_bit_cast(h8, a), __builtin_bit_cast(h8, b), c, 0, 0, 0); }
    else return __builtin_amdgcn_mfma_f32_16x16x32_bf16(a, b, c, 0, 0, 0);
}
template <class Epi, class Sched, bool ALIGN_EPI = false, bool SP2 = false, bool F16 = false>
__device__ __forceinline__ void gemm_phase(PG8_LAS unsigned char* lds, const Gemm g, const Sched& S, const Epi& E) {
    const int tid = threadIdx.x, wid = __builtin_amdgcn_readfirstlane(tid >> 6), lane = tid & 63, wr = wid >> 2, wc = wid & 3, fr = lane & 15, fq = lane >> 4;
    const int K = g.K, nt = K / BK;
    unsigned voffA[2], voffB[2];
#pragma unroll
    for (int i = 0; i < 2; ++i) { int R, C; stage_rc(tid * 16 + i * 8192, R, C); const int Rb = Epi::PERM ? ((R & ~31) + perm32(R & 31)) : R;
        voffA[i] = (unsigned)(R * K + C) * 2u; voffB[i] = (unsigned)(Rb * K + C) * 2u; }
    const size_t kstep = (size_t)(BK * 2);
    const size_t hstep = (size_t)HALF * K * 2;
    const size_t tstep = 2 * hstep;
    const unsigned ldsw = (unsigned)wid * 1024u;
    const int aoff = lds_byte(wr * 64 + fr, fq * 8), boff = lds_byte(wc * 32 + fr, fq * 8);
#define PG8_SA(b, h) (((b) * 2 + (h)) * HTB)
#define PG8_SB(b, h) ((4 + (b) * 2 + (h)) * HTB)
#define PG8_STAGE(bufoff, gbase, voff) do { _Pragma("unroll") for (int _i = 0; _i < 2; ++_i) \
        __builtin_amdgcn_global_load_lds((const unsigned*)((const char*)(gbase) + (voff)[_i]), (PG8_LAS unsigned*)(lds + (bufoff) + ldsw + _i * 8192), 16, 0, 0); } while (0)
#define PG8_LDA(dst, b, h) do { _Pragma("unroll") for (int m = 0; m < 4; ++m) _Pragma("unroll") for (int k = 0; k < 2; ++k) dst[m][k] = *(const PG8_LAS bf16x8*)(lds + PG8_SA(b, h) + aoff + m * 2048 + k * 1024); } while (0)
#define PG8_LDB(dst, b, h) do { _Pragma("unroll") for (int n = 0; n < 2; ++n) _Pragma("unroll") for (int k = 0; k < 2; ++k) dst[n][k] = *(const PG8_LAS bf16x8*)(lds + PG8_SB(b, h) + boff + n * 2048 + k * 1024); } while (0)
#define PG8_MMA(ai, bj, At, Bt) do { __builtin_amdgcn_s_setprio(1); _Pragma("unroll") for (int m = 0; m < 4; ++m) _Pragma("unroll") for (int n = 0; n < 2; ++n) _Pragma("unroll") for (int k = 0; k < 2; ++k) \
        acc[ai][bj][m][n] = mma16<F16>(Bt[n][k], At[m][k], acc[ai][bj][m][n]); __builtin_amdgcn_s_setprio(0); } while (0)
#define PG8_WAIT_V(n) asm volatile("s_waitcnt vmcnt(" #n ")" ::: "memory")
#define PG8_WAIT_L(n) asm volatile("s_waitcnt lgkmcnt(" #n ")" ::: "memory")
#define PG8_BAR __builtin_amdgcn_s_barrier()
#define PG8_SCHED __builtin_amdgcn_sched_barrier(0)
    Unit cur, nxt; int ui = 0;
    if (!S.next(0, cur)) return;
    f32x4 acc[2][2][4][2];
#pragma unroll
    for (int a = 0; a < 2; ++a)
#pragma unroll
        for (int b = 0; b < 2; ++b)
#pragma unroll
            for (int m = 0; m < 4; ++m)
#pragma unroll
                for (int n = 0; n < 2; ++n) acc[a][b][m][n] = (f32x4){0.f, 0.f, 0.f, 0.f};
    bf16x8 At[4][2], B0[2][2], B1[2][2];
    const char* cA = (const char*)g.A + (size_t)cur.pm * tstep; const char* cB = (const char*)g.Bt + (size_t)cur.pn * tstep;
    S.a_ready(cur);
    if constexpr (SP2) {
        PG8_STAGE(PG8_SB(0, 0), cB, voffB); PG8_STAGE(PG8_SB(0, 1), cB + hstep, voffB); PG8_STAGE(PG8_SA(0, 0), cA, voffA); PG8_STAGE(PG8_SA(0, 1), cA + hstep, voffA);
        if (wr == 1) PG8_BAR;
        PG8_WAIT_V(2); PG8_BAR;
        PG8_STAGE(PG8_SB(1, 0), cB + kstep, voffB); PG8_STAGE(PG8_SA(1, 0), cA + kstep, voffA); PG8_STAGE(PG8_SB(1, 1), cB + hstep + kstep, voffB);
        PG8_WAIT_V(6); PG8_BAR;
    } else {
        PG8_STAGE(PG8_SB(0, 0), cB, voffB); PG8_STAGE(PG8_SA(0, 0), cA, voffA); PG8_STAGE(PG8_SB(0, 1), cB + hstep, voffB); PG8_STAGE(PG8_SA(0, 1), cA + hstep, voffA);
        if (wr == 1) PG8_BAR;
        PG8_WAIT_V(4); PG8_BAR;
        PG8_STAGE(PG8_SB(1, 0), cB + kstep, voffB); PG8_STAGE(PG8_SA(1, 0), cA + kstep, voffA); PG8_STAGE(PG8_SB(1, 1), cB + hstep + kstep, voffB);
        PG8_WAIT_V(6); PG8_BAR;
    }
    for (;;) {
        const bool has_next = S.next(ui + 1, nxt);
        const char* nA = has_next ? (const char*)g.A + (size_t)nxt.pm * tstep : cA; const char* nB = has_next ? (const char*)g.Bt + (size_t)nxt.pn * tstep : cB;
#pragma unroll 1
        for (int t = 0; t < nt; t += 2) {
            const bool last = (t == nt - 2);
            if constexpr (Epi::KPF) E.kpf(cur, t >> 1, tid, lds + STAGE_BYTES);
            const char* a1 = cA + (size_t)(t + 1) * kstep;
            const char* a2 = last ? nA : cA + (size_t)(t + 2) * kstep; const char* b2 = last ? nB : cB + (size_t)(t + 2) * kstep;
            const char* a3 = a2 + kstep; const char* b3 = b2 + kstep;
            if (last && has_next) S.a_ready(nxt);
            if constexpr (SP2) {
            PG8_LDB(B0, 0, 0); PG8_LDB(B1, 0, 1); PG8_SCHED; PG8_LDA(At, 0, 0); PG8_STAGE(PG8_SA(1, 1), a1 + hstep, voffA);
            PG8_WAIT_V(8); PG8_WAIT_L(0); PG8_BAR; PG8_MMA(0, 0, At, B0); PG8_MMA(0, 1, At, B1); PG8_BAR; PG8_SCHED;
            PG8_LDA(At, 0, 1); PG8_STAGE(PG8_SB(0, 0), b2, voffB); PG8_STAGE(PG8_SB(0, 1), b2 + hstep, voffB); PG8_STAGE(PG8_SA(0, 0), a2, voffA);
            PG8_WAIT_V(8); PG8_WAIT_L(0); PG8_BAR; PG8_MMA(1, 0, At, B0); PG8_MMA(1, 1, At, B1); PG8_BAR; PG8_SCHED;
            PG8_LDB(B0, 1, 0); PG8_LDB(B1, 1, 1); PG8_SCHED; PG8_LDA(At, 1, 0); PG8_STAGE(PG8_SA(0, 1), a2 + hstep, voffA);
            PG8_WAIT_V(8); PG8_WAIT_L(0); PG8_BAR; PG8_MMA(0, 0, At, B0); PG8_MMA(0, 1, At, B1); PG8_BAR; PG8_SCHED;
            PG8_LDA(At, 1, 1); PG8_STAGE(PG8_SB(1, 0), b3, voffB); PG8_STAGE(PG8_SB(1, 1), b3 + hstep, voffB); PG8_STAGE(PG8_SA(1, 0), a3, voffA);
            PG8_WAIT_V(8); PG8_WAIT_L(0); PG8_BAR; PG8_MMA(1, 0, At, B0); PG8_MMA(1, 1, At, B1); PG8_BAR; PG8_SCHED;
            } else {
            PG8_LDB(B0, 0, 0); PG8_SCHED; PG8_LDA(At, 0, 0); PG8_STAGE(PG8_SA(1, 1), a1 + hstep, voffA);
            PG8_WAIT_L(8); PG8_BAR; PG8_WAIT_L(0); PG8_MMA(0, 0, At, B0); PG8_BAR; PG8_SCHED;
            PG8_LDB(B1, 0, 1); PG8_STAGE(PG8_SB(0, 0), b2, voffB);
            PG8_BAR; PG8_WAIT_L(0); PG8_MMA(0, 1, At, B1); PG8_BAR;
            PG8_LDA(At, 0, 1); PG8_STAGE(PG8_SA(0, 0), a2, voffA);
            PG8_BAR; PG8_WAIT_L(0); PG8_MMA(1, 0, At, B0); PG8_BAR; PG8_SCHED;
            PG8_STAGE(PG8_SB(0, 1), b2 + hstep, voffB);
            PG8_WAIT_V(6); PG8_BAR; PG8_MMA(1, 1, At, B1); PG8_BAR;
            PG8_LDB(B0, 1, 0); PG8_SCHED; PG8_LDA(At, 1, 0); PG8_STAGE(PG8_SA(0, 1), a2 + hstep, voffA);
            PG8_WAIT_L(8); PG8_BAR; PG8_WAIT_L(0); PG8_MMA(0, 0, At, B0); PG8_BAR; PG8_SCHED;
            PG8_LDB(B1, 1, 1); PG8_STAGE(PG8_SB(1, 0), b3, voffB);
            PG8_BAR; PG8_WAIT_L(0); PG8_MMA(0, 1, At, B1); PG8_BAR;
            PG8_LDA(At, 1, 1); PG8_STAGE(PG8_SA(1, 0), a3, voffA);
            PG8_BAR; PG8_WAIT_L(0); PG8_MMA(1, 0, At, B0); PG8_BAR; PG8_SCHED;
            PG8_STAGE(PG8_SB(1, 1), b3 + hstep, voffB);
            PG8_WAIT_V(6); PG8_BAR; PG8_MMA(1, 1, At, B1); PG8_BAR;
            }
        }
        if constexpr (ALIGN_EPI) { if (wr == 0) PG8_BAR; }
        if constexpr (!Epi::AFTER_DRAIN) { E(acc, cur, wr, wc, fr, fq); S.done(cur); }
        if (!has_next) break;
#pragma unroll
        for (int a = 0; a < 2; ++a)
#pragma unroll
            for (int b = 0; b < 2; ++b)
#pragma unroll
                for (int m = 0; m < 4; ++m)
#pragma unroll
                    for (int n = 0; n < 2; ++n) acc[a][b][m][n] = (f32x4){0.f, 0.f, 0.f, 0.f};
        cur = nxt; cA = nA; cB = nB; ++ui;
        if constexpr (ALIGN_EPI) { if (wr == 1) PG8_BAR; }
    }
    PG8_WAIT_V(0);
    if constexpr (!ALIGN_EPI) { if (wr == 0) PG8_BAR; }
    PG8_BAR;
    if constexpr (Epi::AFTER_DRAIN) { E.fused(acc, cur, wr, wc, fr, fq, lds, wid, lane); S.done(cur); }
#undef PG8_SA
#undef PG8_SB
#undef PG8_STAGE
#undef PG8_LDA
#undef PG8_LDB
#undef PG8_MMA
#undef PG8_WAIT_V
#undef PG8_WAIT_L
#undef PG8_BAR
#undef PG8_SCHED
}
}

#define LAS __attribute__((address_space(3)))
typedef unsigned short bf16;
typedef unsigned u32x4 __attribute__((ext_vector_type(4)));
typedef unsigned u32x2 __attribute__((ext_vector_type(2)));
typedef float f32x4 __attribute__((ext_vector_type(4)));
typedef short bf16x8 __attribute__((ext_vector_type(8)));
typedef short s16x4 __attribute__((ext_vector_type(4)));

constexpr int DM = 1024, SEQ = 2048, NBATCH = 40, MTOK = NBATCH * SEQ, MPROMPT = 32 * SEQ;
constexpr int NIN = 3328, PLE = 256;
constexpr int NPJ = 2048;
constexpr int C_QA = 0, C_GA = 512, C_QB = 1024, C_GB = 1536;
constexpr float EPS = 1e-6f, L2E = 1.4426950408889634f;
constexpr int NWAVES = 8, NTHREADS = 512;
constexpr int LDS_BYTES = 155648;

constexpr size_t WS_WIN = 0;
constexpr size_t WS_WOUT = WS_WIN + (size_t)NIN * DM * 2;
constexpr size_t WS_WGATE = WS_WOUT + (size_t)DM * DM * 2;
constexpr size_t WS_WPLE = WS_WGATE + (size_t)DM * DM * 2;
constexpr size_t WS_ROPE = WS_WPLE + (size_t)DM * PLE * 2;
constexpr size_t WS_RINV = WS_ROPE + 2048 * 16 * 4;
constexpr size_t WS_CTL = 15u << 20, CTL_BYTES = 16384;
constexpr size_t WS_XN = 16u << 20;
constexpr size_t WS_PBF = WS_XN + (size_t)MTOK * DM * 2;
constexpr size_t WS_PROJ = WS_PBF + (size_t)MTOK * PLE * 2;
constexpr size_t WS_KB = WS_PROJ + (size_t)MTOK * NPJ * 2;
constexpr size_t WS_VB = WS_KB + (size_t)MTOK * 512 * 2;
constexpr size_t WS_KA = WS_VB + (size_t)MTOK * 512 * 2;
constexpr size_t WS_VA = WS_KA + (size_t)MTOK * 128 * 2;
constexpr size_t WS_MIX = WS_VA + (size_t)MTOK * 128 * 2;
constexpr size_t WS_END = WS_MIX + (size_t)MTOK * DM * 2;
static_assert(WS_RINV + (size_t)MTOK * 4 <= WS_CTL && WS_CTL + CTL_BYTES <= WS_XN, "ws map");

__device__ __forceinline__ unsigned f2bf(float f) { unsigned u = __builtin_bit_cast(unsigned, f); return (u + 0x7fffu + ((u >> 16) & 1u)) >> 16; }
typedef float f32x2_t __attribute__((ext_vector_type(2))); typedef __bf16 bf16x2_t __attribute__((ext_vector_type(2)));
__device__ __forceinline__ unsigned pk2(float lo, float hi) { f32x2_t v = {lo, hi}; bf16x2_t b = __builtin_convertvector(v, bf16x2_t); return __builtin_bit_cast(unsigned, b); }
typedef _Float16 f16x2_t __attribute__((ext_vector_type(2)));
__device__ __forceinline__ unsigned pkh2(float lo, float hi) { f32x2_t v = {lo, hi}; f16x2_t h = __builtin_convertvector(v, f16x2_t); return __builtin_bit_cast(unsigned, h); }
__device__ __forceinline__ float hlo(unsigned v) { return (float)__builtin_bit_cast(f16x2_t, v)[0]; }
__device__ __forceinline__ float hhi(unsigned v) { return (float)__builtin_bit_cast(f16x2_t, v)[1]; }
__device__ __forceinline__ float bf2f(unsigned short v) { return __builtin_bit_cast(float, (unsigned)v << 16); }
__device__ __forceinline__ float bflo(unsigned v) { return __builtin_bit_cast(float, v << 16); }
__device__ __forceinline__ float bfhi(unsigned v) { return __builtin_bit_cast(float, v & 0xffff0000u); }
__device__ __forceinline__ float fast_exp2(float x) { return __builtin_amdgcn_exp2f(x); }
__device__ __forceinline__ float fast_rcp(float x) { return __builtin_amdgcn_rcpf(x); }
__device__ __forceinline__ float sigmoidf_(float x) { return fast_rcp(1.0f + fast_exp2(-x * L2E)); }

struct EpiProj {
    static constexpr bool PERM = true, AFTER_DRAIN = false, KPF = false;
    bf16* P; bf16* KA; bf16* VA; bf16* KB; bf16* VB; const float* rinv; const float* qna; const float* kna; const float* qnb; const float* knb; const float* rope;
    __device__ __forceinline__ void operator()(const f32x4 (&acc)[2][2][4][2], const pg8::Unit& u, int wr, int wc, int fr, int fq) const {
        const int pn = u.pn;
        int type = 0; const float* nw = qna; bool rope_on = false; float sc = 1.f;
        bf16* dst = P; int hm_heads = 0, hm_head = 0, tcol = 0;
        if (pn <= 1) { type = 2; nw = qna; rope_on = true; sc = 0.125f; tcol = C_QA + pn * 256 + 64 * wc; }
        else if (pn == 2) { if (wc < 2) { type = 2; nw = kna; rope_on = true; dst = KA; hm_heads = 2; hm_head = wc; } else { dst = VA; hm_heads = 2; hm_head = wc - 2; } }
        else if (pn <= 4) { type = 1; tcol = C_GA + (pn - 3) * 256 + 64 * wc; }
        else if (pn <= 6) { type = 2; nw = qnb; sc = 0.125f; tcol = C_QB + (pn - 5) * 256 + 64 * wc; }
        else if (pn <= 8) { type = 2; nw = knb; dst = KB; hm_heads = 8; hm_head = (pn - 7) * 4 + wc; }
        else if (pn <= 10) { dst = VB; hm_heads = 8; hm_head = (pn - 9) * 4 + wc; }
        else { type = 1; tcol = C_GB + (pn - 11) * 256 + 64 * wc; }
        f32x4 w[2][2];
#pragma unroll
        for (int bj = 0; bj < 2; ++bj)
#pragma unroll
            for (int n = 0; n < 2; ++n) w[bj][n] = *(const f32x4*)(nw + 32 * bj + 8 * fq + 4 * n) * sc;
#pragma unroll
        for (int ai = 0; ai < 2; ++ai)
#pragma unroll
            for (int m = 0; m < 4; ++m) {
                const int row = u.pm * 256 + ai * 128 + wr * 64 + m * 16 + fr;
                const float rs = rinv[row];
                f32x4 v[2][2];
#pragma unroll
                for (int bj = 0; bj < 2; ++bj)
#pragma unroll
                    for (int n = 0; n < 2; ++n) v[bj][n] = acc[ai][bj][m][n] * rs;
                if (type == 2) {
                    float ss = 0.f;
#pragma unroll
                    for (int bj = 0; bj < 2; ++bj)
#pragma unroll
                        for (int n = 0; n < 2; ++n) { const f32x4 x = v[bj][n]; ss += (x[0] * x[0] + x[1] * x[1]) + (x[2] * x[2] + x[3] * x[3]); }
                    ss += __shfl_xor(ss, 16); ss += __shfl_xor(ss, 32);
                    const float rinv = __builtin_amdgcn_rsqf(ss * (1.0f / 64.0f) + EPS);
#pragma unroll
                    for (int bj = 0; bj < 2; ++bj)
#pragma unroll
                        for (int n = 0; n < 2; ++n) v[bj][n] = v[bj][n] * rinv * w[bj][n];
                    if (rope_on) {
                        const int pos = row & (SEQ - 1);
                        const float* rp = rope + pos * 16;
#pragma unroll
                        for (int n = 0; n < 2; ++n) {
                            const f32x4 c = *(const f32x4*)(rp + 4 * n), s = *(const f32x4*)(rp + 8 + 4 * n);
                            f32x4 pv;
#pragma unroll
                            for (int e = 0; e < 4; ++e) pv[e] = __shfl_xor(v[0][n][e], 16);
                            if (fq == 0) v[0][n] = v[0][n] * c - pv * s;
                            else if (fq == 1) v[0][n] = v[0][n] * c + pv * s;
                        }
                    }
                } else if (type == 1) {
#pragma unroll
                    for (int bj = 0; bj < 2; ++bj)
#pragma unroll
                        for (int n = 0; n < 2; ++n)
#pragma unroll
                            for (int e = 0; e < 4; ++e) { const float x = v[bj][n][e]; v[bj][n][e] = x * sigmoidf_(x); }
                }
                bf16* rowp = hm_heads ? dst + ((size_t)((row >> 11) * hm_heads + hm_head) * SEQ + (row & (SEQ - 1))) * 64 + 8 * fq : dst + (size_t)row * NPJ + tcol + 8 * fq;
#pragma unroll
                for (int bj = 0; bj < 2; ++bj) {
                    u32x4 o; o.x = pk2(v[bj][0][0], v[bj][0][1]); o.y = pk2(v[bj][0][2], v[bj][0][3]); o.z = pk2(v[bj][1][0], v[bj][1][1]); o.w = pk2(v[bj][1][2], v[bj][1][3]);
                    *(u32x4*)(rowp + 32 * bj) = o;
                }
            }
    }
};
struct EpiPlain {
    static constexpr bool PERM = true, AFTER_DRAIN = false, KPF = false;
    bf16* O; int ldc;
    __device__ __forceinline__ void operator()(const f32x4 (&acc)[2][2][4][2], const pg8::Unit& u, int wr, int wc, int fr, int fq) const {
        const int row0 = u.pm * 256 + wr * 64 + fr, col0 = u.pn * 256 + wc * 32 + 8 * fq;
#pragma unroll
        for (int ai = 0; ai < 2; ++ai)
#pragma unroll
            for (int m = 0; m < 4; ++m) { bf16* rowp = O + (size_t)(row0 + ai * 128 + m * 16) * ldc + col0;
#pragma unroll
                for (int bj = 0; bj < 2; ++bj) { const f32x4 v0 = acc[ai][bj][m][0], v1 = acc[ai][bj][m][1];
                    u32x4 o; o.x = pk2(v0[0], v0[1]); o.y = pk2(v0[2], v0[3]); o.z = pk2(v1[0], v1[1]); o.w = pk2(v1[2], v1[3]);
                    *(u32x4*)(rowp + bj * 128) = o; } }
    }
};
struct EpiRes {
    static constexpr bool PERM = true, AFTER_DRAIN = false, KPF = false;
    bf16* xh;
    __device__ __forceinline__ void operator()(const f32x4 (&acc)[2][2][4][2], const pg8::Unit& u, int wr, int wc, int fr, int fq) const {
        const int row0 = u.pm * 256 + wr * 64 + fr, col0 = u.pn * 256 + wc * 32 + 8 * fq;
        bf16* hbase = xh + (size_t)row0 * DM + col0;
#pragma unroll
        for (int ai = 0; ai < 2; ++ai) {
            u32x4 xw[4][2];
#pragma unroll
            for (int m = 0; m < 4; ++m)
#pragma unroll
                for (int bj = 0; bj < 2; ++bj) xw[m][bj] = *(const u32x4*)(hbase + (size_t)(ai * 128 + m * 16) * DM + bj * 128);
#pragma unroll
            for (int m = 0; m < 4; ++m)
#pragma unroll
                for (int bj = 0; bj < 2; ++bj) { const size_t off = (size_t)(ai * 128 + m * 16) * DM + bj * 128;
                    const f32x4 a0 = acc[ai][bj][m][0], a1 = acc[ai][bj][m][1]; const u32x4 x4 = xw[m][bj];
                    u32x4 w; w.x = pkh2(hlo(x4.x) + a0[0], hhi(x4.x) + a0[1]); w.y = pkh2(hlo(x4.y) + a0[2], hhi(x4.y) + a0[3]);
                    w.z = pkh2(hlo(x4.z) + a1[0], hhi(x4.z) + a1[1]); w.w = pkh2(hlo(x4.w) + a1[2], hhi(x4.w) + a1[3]); *(u32x4*)(hbase + off) = w; }
            asm volatile("" ::: "memory");
        }
    }
};
struct EpiGate {
#ifndef GATE_PERM
#define GATE_PERM 1
#endif
    static constexpr bool PERM = (GATE_PERM != 0), AFTER_DRAIN = false, KPF = false;
    const bf16* ple; const bf16* xh; float* out; float* dup;
    __device__ __forceinline__ void operator()(const f32x4 (&acc)[2][2][4][2], const pg8::Unit& u, int wr, int wc, int fr, int fq) const {
        if constexpr (PERM) {
        const int row0 = u.pm * 256 + wr * 64 + fr, col0 = u.pn * 256 + wc * 32 + 8 * fq;
        float* obase = out + (size_t)row0 * DM + col0; const bf16* hbase = xh + (size_t)row0 * DM + col0; const bf16* pbase = ple + (size_t)row0 * DM + col0;
#pragma unroll
        for (int ai = 0; ai < 2; ++ai) {
            u32x4 xw[4][2], pw[4][2];
#pragma unroll
            for (int m = 0; m < 4; ++m)
#pragma unroll
                for (int bj = 0; bj < 2; ++bj) { const size_t off = (size_t)(ai * 128 + m * 16) * DM + bj * 128; xw[m][bj] = *(const u32x4*)(hbase + off); pw[m][bj] = *(const u32x4*)(pbase + off); }
#pragma unroll
            for (int m = 0; m < 4; ++m)
#pragma unroll
                for (int bj = 0; bj < 2; ++bj) { const size_t off = (size_t)(ai * 128 + m * 16) * DM + bj * 128;
                    const f32x4 a0 = acc[ai][bj][m][0], a1 = acc[ai][bj][m][1]; const u32x4 p4 = pw[m][bj], x4 = xw[m][bj];
                    f32x4 o0, o1;
                    o0[0] = hlo(x4.x) + bflo(p4.x) * sigmoidf_(a0[0]); o0[1] = hhi(x4.x) + bfhi(p4.x) * sigmoidf_(a0[1]);
                    o0[2] = hlo(x4.y) + bflo(p4.y) * sigmoidf_(a0[2]); o0[3] = hhi(x4.y) + bfhi(p4.y) * sigmoidf_(a0[3]);
                    o1[0] = hlo(x4.z) + bflo(p4.z) * sigmoidf_(a1[0]); o1[1] = hhi(x4.z) + bfhi(p4.z) * sigmoidf_(a1[1]);
                    o1[2] = hlo(x4.w) + bflo(p4.w) * sigmoidf_(a1[2]); o1[3] = hhi(x4.w) + bfhi(p4.w) * sigmoidf_(a1[3]);
                    *(f32x4*)(obase + off) = o0; *(f32x4*)(obase + off + 4) = o1;
#ifdef DUPSTORE
                    *(f32x4*)(dup + (obase - out) + off) = o0; *(f32x4*)(dup + (obase - out) + off + 4) = o1;
#endif
                    }
            asm volatile("" ::: "memory");
        }
        } else {
        const int row0 = u.pm * 256 + wr * 64 + fr, col0 = u.pn * 256 + wc * 32 + 4 * fq;
        float* obase = out + (size_t)row0 * DM + col0; const bf16* hbase = xh + (size_t)row0 * DM + col0; const bf16* pbase = ple + (size_t)row0 * DM + col0;
#pragma unroll
        for (int ai = 0; ai < 2; ++ai) {
            u32x2 xw[4][2][2], pw[4][2][2];
#pragma unroll
            for (int m = 0; m < 4; ++m)
#pragma unroll
                for (int bj = 0; bj < 2; ++bj)
#pragma unroll
                    for (int n = 0; n < 2; ++n) { const size_t off = (size_t)(ai * 128 + m * 16) * DM + bj * 128 + n * 16; xw[m][bj][n] = *(const u32x2*)(hbase + off); pw[m][bj][n] = *(const u32x2*)(pbase + off); }
#pragma unroll
            for (int m = 0; m < 4; ++m)
#pragma unroll
                for (int bj = 0; bj < 2; ++bj)
#pragma unroll
                    for (int n = 0; n < 2; ++n) { const size_t off = (size_t)(ai * 128 + m * 16) * DM + bj * 128 + n * 16;
                        const f32x4 a0 = acc[ai][bj][m][n]; const u32x2 p2 = pw[m][bj][n], x2 = xw[m][bj][n];
                        f32x4 o0;
                        o0[0] = hlo(x2.x) + bflo(p2.x) * sigmoidf_(a0[0]); o0[1] = hhi(x2.x) + bfhi(p2.x) * sigmoidf_(a0[1]);
                        o0[2] = hlo(x2.y) + bflo(p2.y) * sigmoidf_(a0[2]); o0[3] = hhi(x2.y) + bfhi(p2.y) * sigmoidf_(a0[3]);
                        *(f32x4*)(obase + off) = o0; }
            asm volatile("" ::: "memory");
        }
        }
    }
};

template <bool F16 = false> __device__ __forceinline__ void transpose_item(const float* W, int K, int N, bf16* WT, int k0, int n0, int dst_row0, LAS float* scr, int lane, const float* kscale = nullptr) {
#pragma unroll 8
    for (int i = 0; i < 32; ++i) { const int kk = 2 * i + (lane >> 5); const float sc = kscale ? kscale[k0 + kk] : 1.0f; scr[kk * 33 + (lane & 31)] = W[(size_t)(k0 + kk) * N + n0 + (lane & 31)] * sc; }
    asm volatile("s_waitcnt lgkmcnt(0)" ::: "memory");
    const int c = lane & 7;
#pragma unroll
    for (int j = 0; j < 4; ++j) { const int n = (lane >> 3) + 8 * j; const LAS float* s = scr + (8 * c) * 33 + n;
        u32x4 o;
        if constexpr (F16) { o.x = pkh2(s[0 * 33], s[1 * 33]); o.y = pkh2(s[2 * 33], s[3 * 33]); o.z = pkh2(s[4 * 33], s[5 * 33]); o.w = pkh2(s[6 * 33], s[7 * 33]); }
        else { o.x = pk2(s[0 * 33], s[1 * 33]); o.y = pk2(s[2 * 33], s[3 * 33]); o.z = pk2(s[4 * 33], s[5 * 33]); o.w = pk2(s[6 * 33], s[7 * 33]); }
        *(u32x4*)(WT + (size_t)(dst_row0 + n) * K + k0 + 8 * c) = o; }
    asm volatile("s_waitcnt lgkmcnt(0)" ::: "memory");
}
__device__ __forceinline__ float wave_sum(float v) {
#pragma unroll
    for (int o = 1; o < 64; o <<= 1) v += __shfl_xor(v, o);
    return v;
}

struct Params {
    const float* xp; const float* xs; const float* pp; const float* ps; const float* norm_w; const float* w_in;
    const float* qna; const float* kna; const float* sink; const float* qnb; const float* knb; const float* rpb;
    const float* w_out; const float* w_ple; const float* w_gate; float* out; unsigned char* ws;
    int ph_lo, ph_hi;
};

__device__ __forceinline__ void prologue(const Params& a, LAS unsigned char* lds, int tid, int lane, int wave, int G) {
    LAS float* scr = (LAS float*)(lds + wave * 16384);
    const int gw = blockIdx.x * NWAVES + wave, NGW = G * NWAVES;
    bf16* win_t = (bf16*)(a.ws + WS_WIN); bf16* wout_t = (bf16*)(a.ws + WS_WOUT); bf16* wgate_t = (bf16*)(a.ws + WS_WGATE); bf16* wple_t = (bf16*)(a.ws + WS_WPLE);
    constexpr int I_IN = (DM / 64) * (NIN / 32), I_SQ = (DM / 64) * (DM / 32), I_PLE = (PLE / 64) * (DM / 32);
    constexpr int NITEMS = I_IN + 2 * I_SQ + I_PLE;
    for (int it = gw; it < NITEMS; it += NGW) {
        int r = it;
        if (r < I_IN) { const int nblk = NIN / 32, kb = r / nblk, nb = r % nblk; const int n0 = 32 * nb; const int ga = (n0 & 255) >> 5, gl = 4 * (ga & 1) + (ga >> 1);
            transpose_item<true>(a.w_in, DM, NIN, win_t, 64 * kb, n0, (n0 & ~255) + 32 * gl, scr, lane, a.norm_w); continue; }
        r -= I_IN;
        if (r < I_SQ) { const int kb = r / 32, nb = r % 32; transpose_item(a.w_out, DM, DM, wout_t, 64 * kb, 32 * nb, 32 * nb, scr, lane); continue; }
        r -= I_SQ;
        if (r < I_SQ) { const int kb = r / 32, nb = r % 32; transpose_item<true>(a.w_gate, DM, DM, wgate_t, 64 * kb, 32 * nb, 32 * nb, scr, lane); continue; }
        r -= I_SQ;
        { const int kb = r / 32, nb = r % 32; transpose_item(a.w_ple, PLE, DM, wple_t, 64 * kb, 32 * nb, 32 * nb, scr, lane); }
    }
    {
        float* rope = (float*)(a.ws + WS_ROPE);
        const double inv_freq[8] = {1.0, 0.19392274474868576, 0.03760603093086393, 0.007292664737217109, 0.001414213562373095, 0.0002742481756762073, 5.318295896944988e-05, 1.031338537721246e-05};
        for (int e = blockIdx.x * NTHREADS + tid; e < SEQ * 8; e += G * NTHREADS) {
            const int pos = e >> 3, i = e & 7;
            double f = 1.0;
#pragma unroll
            for (int k = 0; k < 8; ++k) f = (i == k) ? inv_freq[k] : f;
            double t = (double)pos * f * 0.15915494309189535; t -= __builtin_floor(t);
            const float tf = (float)t;
            rope[pos * 16 + i] = __builtin_amdgcn_cosf(tf); rope[pos * 16 + 8 + i] = __builtin_amdgcn_sinf(tf);
        }
    }
    {
        bf16* xh = (bf16*)(a.ws + WS_XN); float* rinv = (float*)(a.ws + WS_RINV);
        constexpr int RB = 4;
        for (int m0 = gw; m0 < MTOK; m0 += RB * NGW) {
            f32x4 v[RB][4];
#pragma unroll
            for (int r = 0; r < RB; ++r) { const int m = m0 + r * NGW;
                if (m < MTOK) { const float* xrow = (m < MPROMPT) ? a.xp + (size_t)m * DM : a.xs + (size_t)(m - MPROMPT) * DM; const f32x4* xr = (const f32x4*)xrow + lane;
#pragma unroll
                    for (int j = 0; j < 4; ++j) v[r][j] = xr[64 * j]; } }
#pragma unroll
            for (int r = 0; r < RB; ++r) { const int m = m0 + r * NGW;
                if (m < MTOK) { float ss = 0.f;
#pragma unroll
                    for (int j = 0; j < 4; ++j) ss += (v[r][j][0] * v[r][j][0] + v[r][j][1] * v[r][j][1]) + (v[r][j][2] * v[r][j][2] + v[r][j][3] * v[r][j][3]);
                    ss = wave_sum(ss);
                    if (lane == 0) rinv[m] = 1.0f / sqrtf(ss * (1.0f / DM) + EPS);
                    u32x2* o8 = (u32x2*)(xh + (size_t)m * DM) + lane;
#pragma unroll
                    for (int j = 0; j < 4; ++j) { u32x2 w2; w2.x = pkh2(v[r][j][0], v[r][j][1]); w2.y = pkh2(v[r][j][2], v[r][j][3]); o8[64 * j] = w2; } } }
        }
    }
    {
        bf16* pbf = (bf16*)(a.ws + WS_PBF);
        const size_t n4 = (size_t)MTOK * PLE / 4, np4 = (size_t)MPROMPT * PLE / 4, stride = (size_t)G * NTHREADS;
        for (size_t e0 = (size_t)blockIdx.x * NTHREADS + tid; e0 < n4; e0 += 4 * stride) {
            f32x4 v[4];
#pragma unroll
            for (int r = 0; r < 4; ++r) { const size_t e = e0 + r * stride; if (e < n4) v[r] = (e < np4) ? ((const f32x4*)a.pp)[e] : ((const f32x4*)a.ps)[e - np4]; }
#pragma unroll
            for (int r = 0; r < 4; ++r) { const size_t e = e0 + r * stride; if (e < n4) { u32x2 w2; w2.x = pk2(v[r][0], v[r][1]); w2.y = pk2(v[r][2], v[r][3]); ((u32x2*)pbf)[e] = w2; } }
        }
    }
}

constexpr int KP = 144, VP = 160;
typedef short v4i16_t __attribute__((ext_vector_type(4)));
__device__ __forceinline__ s16x4 tr_read(const LAS unsigned char* p) { return __builtin_bit_cast(s16x4, __builtin_amdgcn_ds_read_tr16_b64_v4i16((LAS v4i16_t*)p)); }
__device__ __forceinline__ f32x4 mfma16(bf16x8 a, bf16x8 b, f32x4 c) { return __builtin_amdgcn_mfma_f32_16x16x32_bf16(a, b, c, 0, 0, 0); }

template <int NT, int VPITCH> __device__ __forceinline__ void softmax_pv_store(float (&S)[NT][4], float sink_term_valid, float sinkv, const LAS unsigned char* Vs, int vrow0, const int (&vrow)[(NT + 1) / 2],
                                                                   const u32x2 (&gatev)[4], bf16* out_ptr, int i16, int g) {
    float m = sink_term_valid != 0.f ? sinkv : -INFINITY;
#pragma unroll
    for (int t = 0; t < NT; ++t)
#pragma unroll
        for (int r = 0; r < 4; ++r) m = fmaxf(m, S[t][r]);
    m = fmaxf(m, __shfl_xor(m, 16)); m = fmaxf(m, __shfl_xor(m, 32));
    const float mb = m * L2E;
#pragma unroll
    for (int t = 0; t < NT; ++t)
#pragma unroll
        for (int r = 0; r < 4; ++r) S[t][r] = fast_exp2(S[t][r] * L2E - mb);
    f32x4 lsum = (f32x4){0.f, 0.f, 0.f, 0.f};
    const bf16x8 ones = (bf16x8){0x3f80, 0x3f80, 0x3f80, 0x3f80, 0x3f80, 0x3f80, 0x3f80, 0x3f80};
    f32x4 o[4];
#pragma unroll
    for (int dt = 0; dt < 4; ++dt) o[dt] = (f32x4){0.f, 0.f, 0.f, 0.f};
    const LAS unsigned char* vb = Vs + (vrow0 + 4 * g + (i16 >> 2)) * VPITCH + (i16 & 3) * 8;
    constexpr int NS = (NT + 1) / 2;
#pragma unroll
    for (int s = 0; s < NS; ++s) {
        u32x4 pw; pw.x = pk2(S[2 * s][0], S[2 * s][1]); pw.y = pk2(S[2 * s][2], S[2 * s][3]);
        if (2 * s + 1 < NT) { pw.z = pk2(S[(2 * s + 1) < NT ? 2 * s + 1 : 0][0], S[(2 * s + 1) < NT ? 2 * s + 1 : 0][1]); pw.w = pk2(S[(2 * s + 1) < NT ? 2 * s + 1 : 0][2], S[(2 * s + 1) < NT ? 2 * s + 1 : 0][3]); }
        else { pw.z = 0u; pw.w = 0u; }
        const bf16x8 pf = __builtin_bit_cast(bf16x8, pw);
#pragma unroll
        for (int dt = 0; dt < 4; ++dt) {
            const s16x4 lo = tr_read(vb + vrow[s] * VPITCH + dt * 32), hi = tr_read(vb + (vrow[s] + 16) * VPITCH + dt * 32);
            const bf16x8 vf = (bf16x8){lo[0], lo[1], lo[2], lo[3], hi[0], hi[1], hi[2], hi[3]};
            o[dt] = mfma16(vf, pf, o[dt]);
        }
        lsum = mfma16(ones, pf, lsum);
    }
    float l = lsum[0];
    if (sink_term_valid != 0.f) l += fast_exp2(sinkv * L2E - mb);
    const float inv = 1.0f / l;
#pragma unroll
    for (int dt = 0; dt < 4; ++dt) {
        const u32x2 gw = gatev[dt];
        u32x2 w2; w2.x = pk2(o[dt][0] * inv * bflo(gw.x), o[dt][1] * inv * bfhi(gw.x)); w2.y = pk2(o[dt][2] * inv * bflo(gw.y), o[dt][3] * inv * bfhi(gw.y));
        *(u32x2*)(out_ptr + dt * 16 + 4 * g) = w2;
    }
}

struct PfA { u32x4 k[7], v[7]; };
__device__ __forceinline__ void attnA_fetch(PfA& pf, const bf16* KA, const bf16* VA, int u, int tid) {
    const int kh = u & 1, j = (u >> 1) & 15, b = u >> 5, span0 = j * 128 - 128;
#pragma unroll
    for (int i = 0; i < 7; ++i) {
        const int c = tid + NTHREADS * i, row = c >> 3, ch = c & 7, kpos = span0 + row;
        pf.k[i] = (u32x4){0u, 0u, 0u, 0u}; pf.v[i] = (u32x4){0u, 0u, 0u, 0u};
        if (row < 384 && kpos >= 0 && kpos < SEQ) { const size_t o = ((size_t)(b * 2 + kh) * SEQ + kpos) * 64 + ch * 8; pf.k[i] = *(const u32x4*)(KA + o); pf.v[i] = *(const u32x4*)(VA + o); }
    }
}
__device__ __forceinline__ void attnA_commit(const PfA& pf, LAS unsigned char* lds, int tid) {
    LAS unsigned char* Ks = lds; LAS unsigned char* Vs = lds + 384 * KP;
#pragma unroll
    for (int i = 0; i < 7; ++i) {
        const int c = tid + NTHREADS * i, row = c >> 3, ch = c & 7;
        if (row < 384) *(LAS u32x4*)(Ks + row * KP + ch * 16) = pf.k[i];
        if (row < 400) *(LAS u32x4*)(Vs + row * VP + ch * 16) = pf.v[i];
    }
}
template <bool EDGE> __device__ __forceinline__ void attnA_compute(LAS unsigned char* lds, const bf16* proj, bf16* mix, const float* sink, int u, int lane, int wave) {
    const int kh = u & 1, j = (u >> 1) & 15, b = u >> 5;
    const LAS unsigned char* Ks = lds; const LAS unsigned char* Vs = lds + 384 * KP;
    const int i16 = lane & 15, g = lane >> 4;
    const int head = kh * 4 + (wave >> 1);
    const float sinkv = sink[head];
    bf16x8 qf[4][2];
#pragma unroll
    for (int i = 0; i < 4; ++i) { const int qt = (wave & 1) * 4 + i; const size_t tokq = (size_t)b * SEQ + j * 128 + qt * 16 + i16;
        const bf16* qp = proj + tokq * NPJ + C_QA + head * 64 + g * 8; qf[i][0] = *(const bf16x8*)(qp); qf[i][1] = *(const bf16x8*)(qp + 32); }
#pragma unroll
    for (int i = 0; i < 4; ++i) {
        const int qt = (wave & 1) * 4 + i, q0 = j * 128 + qt * 16;
        const size_t tokq = (size_t)b * SEQ + q0 + i16;
        u32x2 gatev[4];
#pragma unroll
        for (int dt = 0; dt < 4; ++dt) gatev[dt] = *(const u32x2*)(proj + tokq * NPJ + C_GA + head * 64 + dt * 16 + 4 * g);
        const bf16x8 qf0 = qf[i][0], qf1 = qf[i][1];
        float S[17][4];
        const LAS unsigned char* kb = Ks + (qt * 16 + i16) * KP + g * 16;
#pragma unroll
        for (int t = 0; t < 17; ++t) {
            const int kpos0 = q0 - 128 + 16 * t;
            if (!EDGE || (kpos0 >= 0 && kpos0 < SEQ)) {
                f32x4 acc = (f32x4){0.f, 0.f, 0.f, 0.f};
                acc = mfma16(*(const LAS bf16x8*)(kb + 16 * t * KP), qf0, acc);
                acc = mfma16(*(const LAS bf16x8*)(kb + 16 * t * KP + 64), qf1, acc);
#pragma unroll
                for (int r = 0; r < 4; ++r) S[t][r] = acc[r];
            } else {
#pragma unroll
                for (int r = 0; r < 4; ++r) S[t][r] = -INFINITY;
            }
        }
#pragma unroll
        for (int r = 0; r < 4; ++r) { if (4 * g + r < i16) S[0][r] = -INFINITY; if (4 * g + r > i16) S[16][r] = -INFINITY; }
        int vrow[9];
#pragma unroll
        for (int ks = 0; ks < 9; ++ks) vrow[ks] = 32 * ks;
        softmax_pv_store<17, VP>(S, 1.f, sinkv, Vs, qt * 16, vrow, gatev, mix + tokq * DM + head * 64, i16, g);
    }
}

__device__ __forceinline__ int clampi(int v, int lo, int hi) { return v < lo ? lo : (v > hi ? hi : v); }
constexpr int VPB = 144;
constexpr int B_RROWS = 512, B_VOFF = B_RROWS * KP, B_TOFF = B_VOFF + B_RROWS * VPB;
static_assert(B_TOFF + 2048 <= LDS_BYTES - 64 && 384 * KP + 400 * VP <= LDS_BYTES - 64, "LDS map");
struct PfB { u32x4 k[6], v[6]; float bias; bf16x8 q0, q1; u32x2 gate[4]; };
__device__ __forceinline__ void attnB_fetch(PfB& pf, const bf16* proj, const bf16* KB, const bf16* VB, const float* rpb, int w, int R, int tid) {
    const int n = w & 3, h = (w >> 2) & 7, b = w >> 5;
    const int nlo = (R == 0) ? 0 : (R == 1) ? 11 : (R == 2) ? 19 : 27, ncnt = (R == 0) ? 11 : (R == 3) ? 5 : 8;
    const int blk = clampi(16 * n - 8, 0, 32);
#pragma unroll
    for (int i = 0; i < 6; ++i) {
        const int c = tid + NTHREADS * i, rowi = c >> 8, kcol = (c >> 3) & 31, ch = c & 7;
        pf.k[i] = (u32x4){0u, 0u, 0u, 0u}; pf.v[i] = (u32x4){0u, 0u, 0u, 0u};
        if (rowi < ncnt) { const size_t o = ((size_t)(b * 8 + h) * SEQ + (nlo + rowi) * 64 + blk + kcol) * 64 + ch * 8; pf.k[i] = *(const u32x4*)(KB + o); pf.v[i] = *(const u32x4*)(VB + o); }
    }
    { const int idx = tid - 16; pf.bias = (idx >= 0 && idx < 465) ? rpb[h * 465 + idx] : 0.f; }
    { const int lane = tid & 63, wave = tid >> 6; const size_t tokq = (size_t)b * SEQ + (8 * R + wave) * 64 + 16 * n + (lane & 15);
      const bf16* qp = proj + tokq * NPJ + C_QB + h * 64 + (lane >> 4) * 8; pf.q0 = *(const bf16x8*)(qp); pf.q1 = *(const bf16x8*)(qp + 32);
#pragma unroll
      for (int dt = 0; dt < 4; ++dt) pf.gate[dt] = *(const u32x2*)(proj + tokq * NPJ + C_GB + h * 64 + dt * 16 + 4 * (lane >> 4)); }
}
__device__ __forceinline__ void attnB_commit(const PfB& pf, LAS unsigned char* lds, int R, int tid) {
    LAS unsigned char* Ks = lds; LAS unsigned char* Vs = lds + B_VOFF; LAS float* tbl = (LAS float*)(lds + B_TOFF);
    const int nlo = (R == 0) ? 0 : (R == 1) ? 11 : (R == 2) ? 19 : 27, ncnt = (R == 0) ? 11 : (R == 3) ? 5 : 8;
#pragma unroll
    for (int i = 0; i < 6; ++i) {
        const int c = tid + NTHREADS * i, rowi = c >> 8, kcol = (c >> 3) & 31, ch = c & 7;
        if (rowi < ncnt) { const int row = ((nlo + rowi) & 15) * 32 + kcol; *(LAS u32x4*)(Ks + row * KP + ch * 16) = pf.k[i]; *(LAS u32x4*)(Vs + row * VPB + ch * 16) = pf.v[i]; }
    }
    if (R == 0) tbl[tid] = pf.bias;
}
__device__ __forceinline__ void attnB_compute(LAS unsigned char* lds, bf16* mix, int w, int R, bf16x8 qf0, bf16x8 qf1, const u32x2 (&gatev)[4], int lane, int wave) {
    const int n = w & 3, h = (w >> 2) & 7, b = w >> 5;
    const LAS unsigned char* Ks = lds; const LAS unsigned char* Vs = lds + B_VOFF; const LAS float* tbl = (const LAS float*)(lds + B_TOFF);
    const int blk = clampi(16 * n - 8, 0, 32);
    const int i16 = lane & 15, g = lane >> 4;
    const int r = 8 * R + wave, rs = clampi(r - 4, 0, 24), c = 16 * n + i16, cs = clampi(c - 8, 0, 48);
    const size_t tokq = (size_t)b * SEQ + r * 64 + c;
    int vrow[8];
#pragma unroll
    for (int a = 0; a < 8; ++a) vrow[a] = ((rs + a) & 15) * 32;
    float S[16][4];
    const LAS unsigned char* kb = Ks + i16 * KP + g * 16;
    const LAS float* tb = tbl + 16 + (rs - r + 7) * 31 + (blk + 4 * g - c + 15);
    const int kc0 = blk + 4 * g;
#pragma unroll
    for (int t = 0; t < 16; ++t) {
        const int a = t >> 1, ch = t & 1;
        f32x4 acc = (f32x4){tb[a * 31 + 16 * ch + 0], tb[a * 31 + 16 * ch + 1], tb[a * 31 + 16 * ch + 2], tb[a * 31 + 16 * ch + 3]};
        acc = mfma16(*(const LAS bf16x8*)(kb + (vrow[a] + 16 * ch) * KP), qf0, acc);
        acc = mfma16(*(const LAS bf16x8*)(kb + (vrow[a] + 16 * ch) * KP + 64), qf1, acc);
#pragma unroll
        for (int rr = 0; rr < 4; ++rr) { const int kc = kc0 + 16 * ch + rr; const bool valid = (kc >= cs) && (kc < cs + 16);
            S[t][rr] = valid ? acc[rr] : -INFINITY; }
    }
    softmax_pv_store<16, VPB>(S, 0.f, 0.f, Vs, 0, vrow, gatev, mix + tokq * DM + 512 + h * 64, i16, g);
}
__device__ __forceinline__ void attention_phase(LAS unsigned char* lds, const bf16* proj, const bf16* KA, const bf16* VA, const bf16* KB, const bf16* VB, bf16* mix, const float* sink, const float* rpb, int G, int tid, int lane, int wave) {
    constexpr int NA = NBATCH * 16 * 2, NBU = NBATCH * 8 * 4 * 4;
#ifndef REPA
#define REPA 1
#endif
#ifndef REPB
#define REPB 1
#endif
    for (int repa = 0; repa < REPA; ++repa) {
        int u = blockIdx.x; PfA pf;
        if (u < NA) attnA_fetch(pf, KA, VA, u, tid);
        for (; u < NA; u += G) {
            attnA_commit(pf, lds, tid);
            __syncthreads();
            if (u + G < NA) attnA_fetch(pf, KA, VA, u + G, tid);
            { const int jj = (u >> 1) & 15; if (jj == 0 || jj == 15) attnA_compute<true>(lds, proj, mix, sink, u, lane, wave); else attnA_compute<false>(lds, proj, mix, sink, u, lane, wave); }
            __syncthreads();
        }
    }
    for (int repb = 0; repb < REPB; ++repb) {
        constexpr int NW = NBATCH * 8 * 4;
        int w = blockIdx.x, R = 0; PfB pf;
        if (w < NW) attnB_fetch(pf, proj, KB, VB, rpb, w, 0, tid);
        while (w < NW) {
            attnB_commit(pf, lds, R, tid);
            const bf16x8 qf0 = pf.q0, qf1 = pf.q1; u32x2 gatev[4];
#pragma unroll
            for (int dt = 0; dt < 4; ++dt) gatev[dt] = pf.gate[dt];
            __syncthreads();
            const int wn = (R == 3) ? w + G : w, Rn = (R + 1) & 3;
            if (wn < NW) attnB_fetch(pf, proj, KB, VB, rpb, wn, Rn, tid);
            attnB_compute(lds, mix, w, R, qf0, qf1, gatev, lane, wave);
            __syncthreads();
            w = wn; R = Rn;
        }
    }
}

#define XB_TMO      128
#define XB_XCNT(j)  (256  + 64 * (j))
#define XB_XSUB(j)  (1280 + 64 * (j))
#define XB_XGEN(j)  (2304 + 64 * (j))
#define XB_TOP      3328
#define XB_TOPGEN   3392
#define XCD_BAR_WORDS 3456
#define XB_SPIN_CAP (1u << 18)

__device__ __forceinline__ unsigned xb_ld(unsigned* p)              { return __hip_atomic_load(p, __ATOMIC_RELAXED, __HIP_MEMORY_SCOPE_AGENT); }
__device__ __forceinline__ unsigned xb_add(unsigned* p, unsigned v) { return __hip_atomic_fetch_add(p, v, __ATOMIC_RELAXED, __HIP_MEMORY_SCOPE_AGENT); }
__device__ __forceinline__ unsigned xb_xcc_id() { return (unsigned)__builtin_amdgcn_s_getreg((3 << 11) | 20) & 0xFu; }
#define XB_SPIN(cond, bar) do { unsigned _sp = 0; while (cond) { __builtin_amdgcn_s_sleep(1); \
    if ((++_sp & 255u) == 0u) { if (xb_ld(&(bar)[XB_TMO])) break; if (_sp > XB_SPIN_CAP) { atomicAdd(&(bar)[XB_TMO], 1u); break; } } } } while (0)

struct XcdBarrier {
    unsigned* bar; unsigned x;
    volatile LAS unsigned* st;
};

__device__ __forceinline__ XcdBarrier xcd_barrier_post(unsigned* bar, volatile LAS unsigned* st) {
    XcdBarrier b; b.bar = bar; b.x = xb_xcc_id(); b.st = st;
    if (threadIdx.x == 0) (void)xb_add(&bar[XB_XCNT(b.x)], 1u);
    return b;
}
__device__ __forceinline__ void xcd_barrier_complete(unsigned* bar, unsigned x, unsigned& nloc, unsigned& nx) {
    const unsigned G = gridDim.x * gridDim.y * gridDim.z;
    unsigned sum, cnt, mine, sp = 0u;
    for (;;) {
        sum = 0u; cnt = 0u; mine = 0u;
#pragma unroll
        for (unsigned j = 0; j < 16; ++j) { const unsigned c = xb_ld(&bar[XB_XCNT(j)]); sum += c; cnt += (c > 0u) ? 1u : 0u; mine = (j == x) ? c : mine; }
        if (sum == G) break;
        __builtin_amdgcn_s_sleep(1);
        if ((++sp & 255u) == 0u) { if (xb_ld(&bar[XB_TMO])) break; if (sp > XB_SPIN_CAP) { atomicAdd(&bar[XB_TMO], 1u); break; } }
    }
    nloc = mine > 0u ? mine : 1u; nx = cnt > 0u ? cnt : 1u;
}

__device__ __forceinline__ void xcd_barrier(const XcdBarrier& b) {
    asm volatile("s_waitcnt vmcnt(0)" ::: "memory");
    __syncthreads();
    if (threadIdx.x == 0) {
        unsigned* bar = b.bar;
        __builtin_amdgcn_s_waitcnt(0);
        unsigned nloc = b.st[0], nx = b.st[1];
        if (nloc == 0u) { xcd_barrier_complete(bar, b.x, nloc, nx); b.st[0] = nloc; b.st[1] = nx; }
        const unsigned old = xb_add(&bar[XB_XSUB(b.x)], 1u);
        const unsigned gen = old / nloc;
        if (old + 1u == (gen + 1u) * nloc) {
            __builtin_amdgcn_fence(__ATOMIC_RELEASE, "agent");
            asm volatile("s_waitcnt vmcnt(0)" ::: "memory");
            const unsigned og = xb_add(&bar[XB_TOP], 1u);
            const unsigned tg = og / nx;
            if (og + 1u == (tg + 1u) * nx) xb_add(&bar[XB_TOPGEN], 1u);
            else XB_SPIN(xb_ld(&bar[XB_TOPGEN]) == tg, bar);
            __builtin_amdgcn_fence(__ATOMIC_ACQUIRE, "agent");
            xb_add(&bar[XB_XGEN(b.x)], 1u);
            asm volatile("s_waitcnt vmcnt(0)" ::: "memory");
        } else {
            XB_SPIN(xb_ld(&bar[XB_XGEN(b.x)]) == gen, bar);
            __builtin_amdgcn_fence(__ATOMIC_ACQUIRE, "agent");
            asm volatile("s_waitcnt vmcnt(0)" ::: "memory");
        }
    }
    __syncthreads();
}

__global__ void __launch_bounds__(NTHREADS, 2) enc_fwd(Params a) {
    extern __shared__ __attribute__((aligned(16))) unsigned char lds_raw[];
    LAS unsigned char* lds = (LAS unsigned char*)lds_raw;
    const int tid = threadIdx.x, lane = tid & 63, wave = __builtin_amdgcn_readfirstlane(tid >> 6);
    const int G = gridDim.x;
    cg::grid_group grid = cg::this_grid();
    volatile LAS unsigned* misc = (volatile LAS unsigned*)(lds + LDS_BYTES - 64);
    if (tid < 16) misc[tid] = 0u;
    __syncthreads();
    XcdBarrier xbar = xcd_barrier_post((unsigned*)(a.ws + WS_CTL), misc);
    if (a.ph_lo > 1000) grid.sync();
    unsigned char* ws = a.ws;
    bf16* xn = (bf16*)(ws + WS_XN); bf16* pbf = (bf16*)(ws + WS_PBF); bf16* proj = (bf16*)(ws + WS_PROJ); bf16* mix = (bf16*)(ws + WS_MIX); bf16* ple = (bf16*)(ws + WS_KB); float* x2f = (float*)(ws + WS_PROJ);
    const int lo = a.ph_lo, hi = a.ph_hi;
#ifdef PHASE_MASK
#define IN(k) (((PHASE_MASK >> (k)) & 1) && lo <= (k) && (k) < hi)
#else
#define IN(k) (lo <= (k) && (k) < hi)
#endif
#define SEAM(k) do { if (IN(k) && IN((k) + 1)) xcd_barrier(xbar); } while (0)
#ifndef GREP1
#define GREP1 1
#endif
#ifndef GREP3
#define GREP3 1
#endif
#ifndef GREP3B
#define GREP3B 1
#endif
#ifndef GREP4
#define GREP4 1
#endif
#ifndef REP0
#define REP0 1
#endif
#ifndef REP1
#define REP1 1
#endif
#ifndef REP2
#define REP2 1
#endif
#ifndef REP3
#define REP3 1
#endif
    if (IN(0)) for (int rep = 0; rep < REP0; ++rep) prologue(a, lds, tid, lane, wave, G);
    SEAM(0);
#ifdef XSYNC
    for (int q = 0; q < XSYNC; ++q) xcd_barrier(xbar);
#endif
    if (IN(1)) for (int rep = 0; rep < REP1; ++rep) {
        pg8::Gemm g{xn, (const bf16*)(ws + WS_WIN), MTOK, NIN, DM}; pg8::StaticOrder S; S.init(MTOK, NIN, G, (int)blockIdx.x); S.reps = GREP1;
        EpiProj E{proj, (bf16*)(ws + WS_KA), (bf16*)(ws + WS_VA), (bf16*)(ws + WS_KB), (bf16*)(ws + WS_VB), (const float*)(ws + WS_RINV), a.qna, a.kna, a.qnb, a.knb, (const float*)(ws + WS_ROPE)};
        pg8::gemm_phase<EpiProj, pg8::StaticOrder, true, true, true>(lds, g, S, E);
    }
    SEAM(1);
    if (IN(2)) for (int rep = 0; rep < REP2; ++rep) attention_phase(lds, proj, (const bf16*)(ws + WS_KA), (const bf16*)(ws + WS_VA), (const bf16*)(ws + WS_KB), (const bf16*)(ws + WS_VB), mix, a.sink, a.rpb, G, tid, lane, wave);
    SEAM(2);
    if (IN(3)) {
#ifndef STAGGER3
#define STAGGER3 0
#endif
        const int kst = STAGGER3 ? (((blockIdx.x >> 3) & 1) ? STAGGER3 : 0) : 0;
        pg8::Gemm gp{pbf, (const bf16*)(ws + WS_WPLE), MTOK, DM, PLE}; EpiPlain Ep{ple, DM};
        if (kst > 0) { pg8::StaticOrder S; S.init(MTOK, DM, G, (int)blockIdx.x); S.reps = GREP3B; S.i0 = 0; S.i1 = kst;
          pg8::gemm_phase<EpiPlain, pg8::StaticOrder, true, true>(lds, gp, S, Ep); }
        { pg8::Gemm g{mix, (const bf16*)(ws + WS_WOUT), MTOK, DM, DM}; pg8::StaticOrder S; S.init(MTOK, DM, G, (int)blockIdx.x); S.reps = GREP3;
          EpiRes E{xn};
          pg8::gemm_phase<EpiRes, pg8::StaticOrder, true, true>(lds, g, S, E); }
        { pg8::StaticOrder S; S.init(MTOK, DM, G, (int)blockIdx.x); S.reps = GREP3B; S.i0 = kst;
          pg8::gemm_phase<EpiPlain, pg8::StaticOrder, true, true>(lds, gp, S, Ep); }
    }
    SEAM(3);
    if (IN(4)) {
        pg8::Gemm g{xn, (const bf16*)(ws + WS_WGATE), MTOK, DM, DM}; pg8::StaticOrder S; S.init(MTOK, DM, G, (int)blockIdx.x); S.reps = GREP4;
        EpiGate E{ple, xn, a.out, (float*)(ws + WS_PROJ)};
        pg8::gemm_phase<EpiGate, pg8::StaticOrder, true, true, true>(lds, g, S, E);
    }
#undef IN
#undef SEAM
}

#ifndef N_LAUNCHES
#define N_LAUNCHES 1
#endif
extern "C" void kernel_launch(void* const* d_in, const int* in_sizes, int n_in, void* d_out, int out_size, void* d_ws, size_t ws_size, hipStream_t stream) {
    static int grid = 0;
    if (grid == 0) {
        if (ws_size < WS_END) { fprintf(stderr, "kernel_launch: workspace too small (%zu < %zu)\n", ws_size, (size_t)WS_END); grid = -1; return; }
        int dev = 0, cus = 0, per_cu = 0;
        hipGetDevice(&dev);
        hipDeviceGetAttribute(&cus, hipDeviceAttributeMultiprocessorCount, dev);
        hipFuncSetAttribute((const void*)enc_fwd, hipFuncAttributeMaxDynamicSharedMemorySize, LDS_BYTES);
        hipOccupancyMaxActiveBlocksPerMultiprocessor(&per_cu, (const void*)enc_fwd, NTHREADS, LDS_BYTES);
        if (per_cu < 1) { fprintf(stderr, "kernel_launch: occupancy query says %d blocks per CU\n", per_cu); per_cu = 1; }
        grid = cus * 1;
        (void)hipGetLastError();
    }
    if (grid < 0) return;
    Params p{};
    p.xp = (const float*)d_in[0]; p.xs = (const float*)d_in[1]; p.pp = (const float*)d_in[2]; p.ps = (const float*)d_in[3];
    p.norm_w = (const float*)d_in[4]; p.w_in = (const float*)d_in[5]; p.qna = (const float*)d_in[6]; p.kna = (const float*)d_in[7]; p.sink = (const float*)d_in[8];
    p.qnb = (const float*)d_in[9]; p.knb = (const float*)d_in[10]; p.rpb = (const float*)d_in[11]; p.w_out = (const float*)d_in[12]; p.w_ple = (const float*)d_in[13]; p.w_gate = (const float*)d_in[14];
    p.out = (float*)d_out; p.ws = (unsigned char*)d_ws;
    hipMemsetAsync((char*)d_ws + WS_CTL, 0, CTL_BYTES, stream);
#if N_LAUNCHES == 1
    p.ph_lo = 0; p.ph_hi = 5;
    void* args[] = {&p};
    hipError_t e = hipLaunchCooperativeKernel((const void*)enc_fwd, dim3(grid), dim3(NTHREADS), args, LDS_BYTES, stream);
    if (e != hipSuccess) fprintf(stderr, "cooperative launch failed: %s (grid %d)\n", hipGetErrorString(e), grid);
#else
    for (int ph = 0; ph < 5; ++ph) { p.ph_lo = ph; p.ph_hi = ph + 1; hipLaunchKernelGGL(enc_fwd, dim3(grid), dim3(NTHREADS), LDS_BYTES, stream, p); }
#endif
}
```

```cpp
#include <hip/hip_runtime.h>
#include <hip/hip_cooperative_groups.h>
#include <cstdio>
#include <cstdint>
#include <cmath>
namespace cg = cooperative_groups;
#ifndef PG8_WGM
#define PG8_WGM 4
#endif
namespace pg8 {
#define PG8_LAS __attribute__((address_space(3)))
typedef unsigned short bf16_t;
typedef short bf16x8 __attribute__((ext_vector_type(8)));
typedef float f32x4 __attribute__((ext_vector_type(4)));
typedef unsigned u32x4 __attribute__((ext_vector_type(4)));
constexpr int BM = 256, BK = 64, HALF = 128, HTB = HALF * BK * 2  , STAGE_BYTES = 8 * HTB, NXCD = 8, WGM = PG8_WGM;

__host__ __device__ __forceinline__ int lds_byte(int r, int c) { const int st = (r >> 4) * 2 + (c >> 5), rr = r & 15, cc = c & 31, ob = rr * 64 + cc * 2; return st * 1024 + (ob ^ (((ob >> 9) & 1) << 5)); }
__host__ __device__ __forceinline__ void stage_rc(int b, int& R, int& C) { const int st = b / 1024, sb = b % 1024, swz = sb ^ (((sb >> 9) & 1) << 5); R = (st >> 1) * 16 + swz / 64; C = (st & 1) * 32 + (swz % 64) / 2; }
__host__ __device__ __forceinline__ int perm32(int rho) { const int n = rho >> 4, i = rho & 15; return 8 * (i >> 2) + 4 * n + (i & 3); }

struct Unit { int pm, pn; };
struct Gemm { const bf16_t* A; const bf16_t* Bt; int M, N, K; };

struct StaticOrder {
    int nM, nN, nwg, G, c, reps = 1, i0 = 0, i1 = 1 << 30, rev = 0;
    __host__ __device__ void init(int M, int N, int G_, int c_) { nM = M / BM; nN = N / BM; nwg = nM * nN; G = G_; c = c_; }
    __host__ __device__ bool next(int ii, Unit& u) const {
        int i = ii + i0; if (i >= i1) return false;
        if (rev > 0) { if (i >= rev) return false; i = rev - 1 - i; }
        const long L = (long)i * G + c; if (L >= (long)nwg * reps) return false;
        int wgid = (int)(L % nwg); { const int q = nwg / NXCD, r = nwg % NXCD, xcd = wgid % NXCD, off = wgid / NXCD; wgid = (xcd < r ? xcd * (q + 1) : r * (q + 1) + (xcd - r) * q) + off; }
        const int nig = WGM * nN, gid = wgid / nig, fm = gid * WGM, gsz = (nM - fm) < WGM ? (nM - fm) : WGM;
        u.pm = fm + ((wgid % nig) % gsz); u.pn = (wgid % nig) / gsz; return true;
    }
    __device__ __forceinline__ void a_ready(const Unit&) const {}
    __device__ __forceinline__ void done(const Unit&) const {}
};

__device__ __forceinline__ unsigned cvt_pk_bf16(float lo, float hi) { unsigned r; asm volatile("v_cvt_pk_bf16_f32 %0, %1, %2" : "=v"(r) : "v"(lo), "v"(hi)); return r; }
typedef float f32x2 __attribute__((ext_vector_type(2)));
template <bool F16> __device__ __forceinline__ f32x4 mma16(bf16x8 a, bf16x8 b, f32x4 c) {
    if constexpr (F16) { typedef _Float16 h8 __attribute__((ext_vector_type(8))); return __builtin_amdgcn_mfma_f32_16x16x32_f16(__builtin_bit_cast(h8, a), __builtin_bit_cast(h8, b), c, 0, 0, 0); }
    else return __builtin_amdgcn_mfma_f32_16x16x32_bf16(a, b, c, 0, 0, 0);
}
template <class Epi, class Sched, bool ALIGN_EPI = false, bool SP2 = false, bool F16 = false>
__device__ __forceinline__ void gemm_phase(PG8_LAS unsigned char* lds, const Gemm g, const Sched& S, const Epi& E) {
    const int tid = threadIdx.x, wid = __builtin_amdgcn_readfirstlane(tid >> 6), lane = tid & 63, wr = wid >> 2, wc = wid & 3, fr = lane & 15, fq = lane >> 4;
    const int K = g.K, nt = K / BK;
    unsigned voffA[2], voffB[2];
#pragma unroll
    for (int i = 0; i < 2; ++i) { int R, C; stage_rc(tid * 16 + i * 8192, R, C); const int Rb = Epi::PERM ? ((R & ~31) + perm32(R & 31)) : R;
        voffA[i] = (unsigned)(R * K + C) * 2u; voffB[i] = (unsigned)(Rb * K + C) * 2u; }
    const size_t kstep = (size_t)(BK * 2);
    const size_t hstep = (size_t)HALF * K * 2;
    const size_t tstep = 2 * hstep;
    const unsigned ldsw = (unsigned)wid * 1024u;
    const int aoff = lds_byte(wr * 64 + fr, fq * 8), boff = lds_byte(wc * 32 + fr, fq * 8);
#define PG8_SA(b, h) (((b) * 2 + (h)) * HTB)
#define PG8_SB(b, h) ((4 + (b) * 2 + (h)) * HTB)
#define PG8_STAGE(bufoff, gbase, voff) do { _Pragma("unroll") for (int _i = 0; _i < 2; ++_i) \
        __builtin_amdgcn_global_load_lds((const unsigned*)((const char*)(gbase) + (voff)[_i]), (PG8_LAS unsigned*)(lds + (bufoff) + ldsw + _i * 8192), 16, 0, 0); } while (0)
#define PG8_LDA(dst, b, h) do { _Pragma("unroll") for (int m = 0; m < 4; ++m) _Pragma("unroll") for (int k = 0; k < 2; ++k) dst[m][k] = *(const PG8_LAS bf16x8*)(lds + PG8_SA(b, h) + aoff + m * 2048 + k * 1024); } while (0)
#define PG8_LDB(dst, b, h) do { _Pragma("unroll") for (int n = 0; n < 2; ++n) _Pragma("unroll") for (int k = 0; k < 2; ++k) dst[n][k] = *(const PG8_LAS bf16x8*)(lds + PG8_SB(b, h) + boff + n * 2048 + k * 1024); } while (0)
#define PG8_MMA(ai, bj, At, Bt) do { __builtin_amdgcn_s_setprio(1); _Pragma("unroll") for (int m = 0; m < 4; ++m) _Pragma("unroll") for (int n = 0; n < 2; ++n) _Pragma("unroll") for (int k = 0; k < 2; ++k) \
        acc[ai][bj][m][n] = mma16<F16>(Bt[n][k], At[m][k], acc[ai][bj][m][n]); __builtin_amdgcn_s_setprio(0); } while (0)
#define PG8_WAIT_V(n) asm volatile("s_waitcnt vmcnt(" #n ")" ::: "memory")
#define PG8_WAIT_L(n) asm volatile("s_waitcnt lgkmcnt(" #n ")" ::: "memory")
#define PG8_BAR __builtin_amdgcn_s_barrier()
#define PG8_SCHED __builtin_amdgcn_sched_barrier(0)
    Unit cur, nxt; int ui = 0;
    if (!S.next(0, cur)) return;
    f32x4 acc[2][2][4][2];
#pragma unroll
    for (int a = 0; a < 2; ++a)
#pragma unroll
        for (int b = 0; b < 2; ++b)
#pragma unroll
            for (int m = 0; m < 4; ++m)
#pragma unroll
                for (int n = 0; n < 2; ++n) acc[a][b][m][n] = (f32x4){0.f, 0.f, 0.f, 0.f};
    bf16x8 At[4][2], B0[2][2], B1[2][2];
    const char* cA = (const char*)g.A + (size_t)cur.pm * tstep; const char* cB = (const char*)g.Bt + (size_t)cur.pn * tstep;
    S.a_ready(cur);
    if constexpr (SP2) {
        PG8_STAGE(PG8_SB(0, 0), cB, voffB); PG8_STAGE(PG8_SB(0, 1), cB + hstep, voffB); PG8_STAGE(PG8_SA(0, 0), cA, voffA); PG8_STAGE(PG8_SA(0, 1), cA + hstep, voffA);
        if (wr == 1) PG8_BAR;
        PG8_WAIT_V(2); PG8_BAR;
        PG8_STAGE(PG8_SB(1, 0), cB + kstep, voffB); PG8_STAGE(PG8_SA(1, 0), cA + kstep, voffA); PG8_STAGE(PG8_SB(1, 1), cB + hstep + kstep, voffB);
        PG8_WAIT_V(6); PG8_BAR;
    } else {
        PG8_STAGE(PG8_SB(0, 0), cB, voffB); PG8_STAGE(PG8_SA(0, 0), cA, voffA); PG8_STAGE(PG8_SB(0, 1), cB + hstep, voffB); PG8_STAGE(PG8_SA(0, 1), cA + hstep, voffA);
        if (wr == 1) PG8_BAR;
        PG8_WAIT_V(4); PG8_BAR;
        PG8_STAGE(PG8_SB(1, 0), cB + kstep, voffB); PG8_STAGE(PG8_SA(1, 0), cA + kstep, voffA); PG8_STAGE(PG8_SB(1, 1), cB + hstep + kstep, voffB);
        PG8_WAIT_V(6); PG8_BAR;
    }
    for (;;) {
        const bool has_next = S.next(ui + 1, nxt);
        const char* nA = has_next ? (const char*)g.A + (size_t)nxt.pm * tstep : cA; const char* nB = has_next ? (const char*)g.Bt + (size_t)nxt.pn * tstep : cB;
#pragma unroll 1
        for (int t = 0; t < nt; t += 2) {
            const bool last = (t == nt - 2);
            if constexpr (Epi::KPF) E.kpf(cur, t >> 1, tid, lds + STAGE_BYTES);
            const char* a1 = cA + (size_t)(t + 1) * kstep;
            const char* a2 = last ? nA : cA + (size_t)(t + 2) * kstep; const char* b2 = last ? nB : cB + (size_t)(t + 2) * kstep;
            const char* a3 = a2 + kstep; const char* b3 = b2 + kstep;
            if (last && has_next) S.a_ready(nxt);
            if constexpr (SP2) {
            PG8_LDB(B0, 0, 0); PG8_LDB(B1, 0, 1); PG8_SCHED; PG8_LDA(At, 0, 0); PG8_STAGE(PG8_SA(1, 1), a1 + hstep, voffA);
            PG8_WAIT_V(8); PG8_WAIT_L(0); PG8_BAR; PG8_MMA(0, 0, At, B0); PG8_MMA(0, 1, At, B1); PG8_BAR; PG8_SCHED;
            PG8_LDA(At, 0, 1); PG8_STAGE(PG8_SB(0, 0), b2, voffB); PG8_STAGE(PG8_SB(0, 1), b2 + hstep, voffB); PG8_STAGE(PG8_SA(0, 0), a2, voffA);
            PG8_WAIT_V(8); PG8_WAIT_L(0); PG8_BAR; PG8_MMA(1, 0, At, B0); PG8_MMA(1, 1, At, B1); PG8_BAR; PG8_SCHED;
            PG8_LDB(B0, 1, 0); PG8_LDB(B1, 1, 1); PG8_SCHED; PG8_LDA(At, 1, 0); PG8_STAGE(PG8_SA(0, 1), a2 + hstep, voffA);
            PG8_WAIT_V(8); PG8_WAIT_L(0); PG8_BAR; PG8_MMA(0, 0, At, B0); PG8_MMA(0, 1, At, B1); PG8_BAR; PG8_SCHED;
            PG8_LDA(At, 1, 1); PG8_STAGE(PG8_SB(1, 0), b3, voffB); PG8_STAGE(PG8_SB(1, 1), b3 + hstep, voffB); PG8_STAGE(PG8_SA(1, 0), a3, voffA);
            PG8_WAIT_V(8); PG8_WAIT_L(0); PG8_BAR; PG8_MMA(1, 0, At, B0); PG8_MMA(1, 1, At, B1); PG8_BAR; PG8_SCHED;
            } else {
            PG8_LDB(B0, 0, 0); PG8_SCHED; PG8_LDA(At, 0, 0); PG8_STAGE(PG8_SA(1, 1), a1 + hstep, voffA);
            PG8_WAIT_L(8); PG8_BAR; PG8_WAIT_L(0); PG8_MMA(0, 0, At, B0); PG8_BAR; PG8_SCHED;
            PG8_LDB(B1, 0, 1); PG8_STAGE(PG8_SB(0, 0), b2, voffB);
            PG8_BAR; PG8_WAIT_L(0); PG8_MMA(0, 1, At, B1); PG8_BAR;
            PG8_LDA(At, 0, 1); PG8_STAGE(PG8_SA(0, 0), a2, voffA);
            PG8_BAR; PG8_WAIT_L(0); PG8_MMA(1, 0, At, B0); PG8_BAR; PG8_SCHED;
            PG8_STAGE(PG8_SB(0, 1), b2 + hstep, voffB);
            PG8_WAIT_V(6); PG8_BAR; PG8_MMA(1, 1, At, B1); PG8_BAR;
            PG8_LDB(B0, 1, 0); PG8_SCHED; PG8_LDA(At, 1, 0); PG8_STAGE(PG8_SA(0, 1), a2 + hstep, voffA);
            PG8_WAIT_L(8); PG8_BAR; PG8_WAIT_L(0); PG8_MMA(0, 0, At, B0); PG8_BAR; PG8_SCHED;
            PG8_LDB(B1, 1, 1); PG8_STAGE(PG8_SB(1, 0), b3, voffB);
            PG8_BAR; PG8_WAIT_L(0); PG8_MMA(0, 1, At, B1); PG8_BAR;
            PG8_LDA(At, 1, 1); PG8_STAGE(PG8_SA(1, 0), a3, voffA);
            PG8_BAR; PG8_WAIT_L(0); PG8_MMA(1, 0, At, B0); PG8_BAR; PG8_SCHED;
            PG8_STAGE(PG8_SB(1, 1), b3 + hstep, voffB);
            PG8_WAIT_V(6); PG8_BAR; PG8_MMA(1, 1, At, B1); PG8_BAR;
            }
        }
        if constexpr (ALIGN_EPI) { if (wr == 0) PG8_BAR; }
        if constexpr (!Epi::AFTER_DRAIN) { E(acc, cur, wr, wc, fr, fq); S.done(cur); }
        if (!has_next) break;
#pragma unroll
        for (int a = 0; a < 2; ++a)
#pragma unroll
            for (int b = 0; b < 2; ++b)
#pragma unroll
                for (int m = 0; m < 4; ++m)
#pragma unroll
                    for (int n = 0; n < 2; ++n) acc[a][b][m][n] = (f32x4){0.f, 0.f, 0.f, 0.f};
        cur = nxt; cA = nA; cB = nB; ++ui;
        if constexpr (ALIGN_EPI) { if (wr == 1) PG8_BAR; }
    }
    PG8_WAIT_V(0);
    if constexpr (!ALIGN_EPI) { if (wr == 0) PG8_BAR; }
    PG8_BAR;
    if constexpr (Epi::AFTER_DRAIN) { E.fused(acc, cur, wr, wc, fr, fq, lds, wid, lane); S.done(cur); }
#undef PG8_SA
#undef PG8_SB
#undef PG8_STAGE
#undef PG8_LDA
#undef PG8_LDB
#undef PG8_MMA
#undef PG8_WAIT_V
#undef PG8_WAIT_L
#undef PG8_BAR
#undef PG8_SCHED
}
}

#define LAS __attribute__((address_space(3)))
typedef unsigned short bf16;
typedef unsigned u32x4 __attribute__((ext_vector_type(4)));
typedef unsigned u32x2 __attribute__((ext_vector_type(2)));
typedef float f32x4 __attribute__((ext_vector_type(4)));
typedef short bf16x8 __attribute__((ext_vector_type(8)));
typedef short s16x4 __attribute__((ext_vector_type(4)));

constexpr int DM = 1024, SEQ = 2048, NBATCH = 40, MTOK = NBATCH * SEQ, MPROMPT = 32 * SEQ;
constexpr int NIN = 3328, PLE = 256;
constexpr int NPJ = 2048;
constexpr int C_QA = 0, C_GA = 512, C_QB = 1024, C_GB = 1536;
constexpr float EPS = 1e-6f, L2E = 1.4426950408889634f;
constexpr int NWAVES = 8, NTHREADS = 512;
constexpr int LDS_BYTES = 155648;

constexpr size_t WS_WIN = 0;
constexpr size_t WS_WOUT = WS_WIN + (size_t)NIN * DM * 2;
constexpr size_t WS_WGATE = WS_WOUT + (size_t)DM * DM * 2;
constexpr size_t WS_WPLE = WS_WGATE + (size_t)DM * DM * 2;
constexpr size_t WS_ROPE = WS_WPLE + (size_t)DM * PLE * 2;
constexpr size_t WS_RINV = WS_ROPE + 2048 * 16 * 4;
constexpr size_t WS_CTL = 15u << 20, CTL_BYTES = 16384;
constexpr size_t WS_XN = 16u << 20;
constexpr size_t WS_PBF = WS_XN + (size_t)MTOK * DM * 2;
constexpr size_t WS_PROJ = WS_PBF + (size_t)MTOK * PLE * 2;
constexpr size_t WS_KB = WS_PROJ + (size_t)MTOK * NPJ * 2;
constexpr size_t WS_VB = WS_KB + (size_t)MTOK * 512 * 2;
constexpr size_t WS_KA = WS_VB + (size_t)MTOK * 512 * 2;
constexpr size_t WS_VA = WS_KA + (size_t)MTOK * 128 * 2;
constexpr size_t WS_MIX = WS_VA + (size_t)MTOK * 128 * 2;
constexpr size_t WS_END = WS_MIX + (size_t)MTOK * DM * 2;
static_assert(WS_RINV + (size_t)MTOK * 4 <= WS_CTL && WS_CTL + CTL_BYTES <= WS_XN, "ws map");

__device__ __forceinline__ unsigned f2bf(float f) { unsigned u = __builtin_bit_cast(unsigned, f); return (u + 0x7fffu + ((u >> 16) & 1u)) >> 16; }
typedef float f32x2_t __attribute__((ext_vector_type(2))); typedef __bf16 bf16x2_t __attribute__((ext_vector_type(2)));
__device__ __forceinline__ unsigned pk2(float lo, float hi) { f32x2_t v = {lo, hi}; bf16x2_t b = __builtin_convertvector(v, bf16x2_t); return __builtin_bit_cast(unsigned, b); }
typedef _Float16 f16x2_t __attribute__((ext_vector_type(2)));
__device__ __forceinline__ unsigned pkh2(float lo, float hi) { f32x2_t v = {lo, hi}; f16x2_t h = __builtin_convertvector(v, f16x2_t); return __builtin_bit_cast(unsigned, h); }
__device__ __forceinline__ float hlo(unsigned v) { return (float)__builtin_bit_cast(f16x2_t, v)[0]; }
__device__ __forceinline__ float hhi(unsigned v) { return (float)__builtin_bit_cast(f16x2_t, v)[1]; }
__device__ __forceinline__ float bf2f(unsigned short v) { return __builtin_bit_cast(float, (unsigned)v << 16); }
__device__ __forceinline__ float bflo(unsigned v) { return __builtin_bit_cast(float, v << 16); }
__device__ __forceinline__ float bfhi(unsigned v) { return __builtin_bit_cast(float, v & 0xffff0000u); }
__device__ __forceinline__ float fast_exp2(float x) { return __builtin_amdgcn_exp2f(x); }
__device__ __forceinline__ float fast_rcp(float x) { return __builtin_amdgcn_rcpf(x); }
__device__ __forceinline__ float sigmoidf_(float x) { return fast_rcp(1.0f + fast_exp2(-x * L2E)); }

struct EpiProj {
    static constexpr bool PERM = true, AFTER_DRAIN = false, KPF = false;
    PG8_LAS unsigned char* stg; bf16* P; bf16* KA; bf16* VA; bf16* KB; bf16* VB; const float* rinv; const float* qna; const float* kna; const float* qnb; const float* knb; const float* rope;
    __device__ __forceinline__ void operator()(const f32x4 (&acc)[2][2][4][2], const pg8::Unit& u, int wr, int wc, int fr, int fq) const {
        const int pn = u.pn;
        int type = 0; const float* nw = qna; bool rope_on = false; float sc = 1.f;
        bf16* dst = P; int hm_heads = 0, hm_head = 0, tcol = 0;
        if (pn <= 1) { type = 2; nw = qna; rope_on = true; sc = 0.125f; tcol = C_QA + pn * 256 + 64 * wc; }
        else if (pn == 2) { if (wc < 2) { type = 2; nw = kna; rope_on = true; dst = KA; hm_heads = 2; hm_head = wc; } else { dst = VA; hm_heads = 2; hm_head = wc - 2; } }
        else if (pn <= 4) { type = 1; tcol = C_GA + (pn - 3) * 256 + 64 * wc; }
        else if (pn <= 6) { type = 2; nw = qnb; sc = 0.125f; tcol = C_QB + (pn - 5) * 256 + 64 * wc; }
        else if (pn <= 8) { type = 2; nw = knb; dst = KB; hm_heads = 8; hm_head = (pn - 7) * 4 + wc; }
        else if (pn <= 10) { dst = VB; hm_heads = 8; hm_head = (pn - 9) * 4 + wc; }
        else { type = 1; tcol = C_GB + (pn - 11) * 256 + 64 * wc; }
        f32x4 w[2][2];
#pragma unroll
        for (int bj = 0; bj < 2; ++bj)
#pragma unroll
            for (int n = 0; n < 2; ++n) w[bj][n] = *(const f32x4*)(nw + 32 * bj + 8 * fq + 4 * n) * sc;
        float rsv[2][4];
#pragma unroll
        for (int ai = 0; ai < 2; ++ai)
#pragma unroll
            for (int m = 0; m < 4; ++m) rsv[ai][m] = rinv[u.pm * 256 + ai * 128 + wr * 64 + m * 16 + fr];
        f32x4 rc[2][2], rsn[2][2];
        if (rope_on) { const float* rp = rope + ((u.pm * 256 + wr * 64 + fr) & (SEQ - 1)) * 16;
#pragma unroll
            for (int n = 0; n < 2; ++n) { rc[0][n] = *(const f32x4*)(rp + 4 * n); rsn[0][n] = *(const f32x4*)(rp + 8 + 4 * n); } }
#pragma unroll
        for (int ai = 0; ai < 2; ++ai)
#pragma unroll
            for (int m = 0; m < 4; ++m) {
                const int row = u.pm * 256 + ai * 128 + wr * 64 + m * 16 + fr;
                const float rs = rsv[ai][m];
                f32x4 v[2][2];
#pragma unroll
                for (int bj = 0; bj < 2; ++bj)
#pragma unroll
                    for (int n = 0; n < 2; ++n) v[bj][n] = acc[ai][bj][m][n] * rs;
                if (type == 2) {
                    float ss = 0.f;
#pragma unroll
                    for (int bj = 0; bj < 2; ++bj)
#pragma unroll
                        for (int n = 0; n < 2; ++n) { const f32x4 x = v[bj][n]; ss += (x[0] * x[0] + x[1] * x[1]) + (x[2] * x[2] + x[3] * x[3]); }
                    ss += __shfl_xor(ss, 16); ss += __shfl_xor(ss, 32);
                    const float rinv = __builtin_amdgcn_rsqf(ss * (1.0f / 64.0f) + EPS);
#pragma unroll
                    for (int bj = 0; bj < 2; ++bj)
#pragma unroll
                        for (int n = 0; n < 2; ++n) v[bj][n] = v[bj][n] * rinv * w[bj][n];
                    if (rope_on) {
                        constexpr int dummy_ = 0; (void)dummy_;
                        const int it = ai * 4 + m;
                        if (it < 7) { const int nai = (it + 1) >> 2, nm = (it + 1) & 3; const float* rpn = rope + ((u.pm * 256 + nai * 128 + wr * 64 + nm * 16 + fr) & (SEQ - 1)) * 16;
#pragma unroll
                            for (int n = 0; n < 2; ++n) { rc[(it + 1) & 1][n] = *(const f32x4*)(rpn + 4 * n); rsn[(it + 1) & 1][n] = *(const f32x4*)(rpn + 8 + 4 * n); } }
#pragma unroll
                        for (int n = 0; n < 2; ++n) {
                            const f32x4 c = rc[it & 1][n], s = rsn[it & 1][n];
                            f32x4 pv;
#pragma unroll
                            for (int e = 0; e < 4; ++e) pv[e] = __shfl_xor(v[0][n][e], 16);
                            if (fq == 0) v[0][n] = v[0][n] * c - pv * s;
                            else if (fq == 1) v[0][n] = v[0][n] * c + pv * s;
                        }
                    }
                } else if (type == 1) {
#pragma unroll
                    for (int bj = 0; bj < 2; ++bj)
#pragma unroll
                        for (int n = 0; n < 2; ++n)
#pragma unroll
                            for (int e = 0; e < 4; ++e) { const float x = v[bj][n][e]; v[bj][n][e] = x * sigmoidf_(x); }
                }
                { PG8_LAS unsigned char* my = stg + (wr * 4 + wc) * 2304; const int ln = fq * 16 + fr;
#pragma unroll
                  for (int bj = 0; bj < 2; ++bj) {
                      u32x4 o; o.x = pk2(v[bj][0][0], v[bj][0][1]); o.y = pk2(v[bj][0][2], v[bj][0][3]); o.z = pk2(v[bj][1][0], v[bj][1][1]); o.w = pk2(v[bj][1][2], v[bj][1][3]);
                      *(PG8_LAS u32x4*)(my + fr * 144 + bj * 64 + fq * 16) = o; }
                  const u32x4 r0 = *(const PG8_LAS u32x4*)(my + (ln >> 3) * 144 + (ln & 7) * 16), r1 = *(const PG8_LAS u32x4*)(my + ((ln >> 3) + 8) * 144 + (ln & 7) * 16);
                  const int rg = u.pm * 256 + ai * 128 + wr * 64 + m * 16 + (ln >> 3);
                  bf16* gp = hm_heads ? dst + ((size_t)((rg >> 11) * hm_heads + hm_head) * SEQ + (rg & (SEQ - 1))) * 64 + (ln & 7) * 8 : dst + (size_t)rg * NPJ + tcol + (ln & 7) * 8;
                  *(u32x4*)gp = r0; *(u32x4*)(gp + (hm_heads ? 8 * 64 : 8 * NPJ)) = r1; }
            }
    }
};
constexpr int PLE_LDR = 2 * DM;
struct EpiPlain {
    static constexpr bool PERM = true, AFTER_DRAIN = false, KPF = false;
    bf16* O; int ldc; PG8_LAS unsigned char* stg;
    __device__ __forceinline__ void operator()(const f32x4 (&acc)[2][2][4][2], const pg8::Unit& u, int wr, int wc, int fr, int fq) const {
        PG8_LAS unsigned char* my = stg + (wr * 4 + wc) * 2304; const int ln = fq * 16 + fr;
#pragma unroll
        for (int ai = 0; ai < 2; ++ai)
#pragma unroll
            for (int m = 0; m < 4; ++m) {
#pragma unroll
                for (int bj = 0; bj < 2; ++bj) { const f32x4 v0 = acc[ai][bj][m][0], v1 = acc[ai][bj][m][1];
                    u32x4 o; o.x = pk2(v0[0], v0[1]); o.y = pk2(v0[2], v0[3]); o.z = pk2(v1[0], v1[1]); o.w = pk2(v1[2], v1[3]);
                    *(PG8_LAS u32x4*)(my + fr * 144 + bj * 64 + fq * 16) = o; }
                const u32x4 r0 = *(const PG8_LAS u32x4*)(my + (ln >> 3) * 144 + (ln & 7) * 16), r1 = *(const PG8_LAS u32x4*)(my + ((ln >> 3) + 8) * 144 + (ln & 7) * 16);
                bf16* gp = O + (size_t)(u.pm * 256 + ai * 128 + wr * 64 + m * 16 + (ln >> 3)) * PLE_LDR + u.pn * 512 + wc * 128 + (ln & 7) * 8;
                *(u32x4*)gp = r0; *(u32x4*)(gp + (size_t)8 * PLE_LDR) = r1; }
    }
};
struct EpiRes {
    static constexpr bool PERM = true, AFTER_DRAIN = false, KPF = false;
    bf16* xh; PG8_LAS unsigned char* stg;
    __device__ __forceinline__ void operator()(const f32x4 (&acc)[2][2][4][2], const pg8::Unit& u, int wr, int wc, int fr, int fq) const {
        PG8_LAS unsigned char* my = stg + (wr * 4 + wc) * 2304; const int ln = fq * 16 + fr;
        bf16* sbase = xh + (size_t)(u.pm * 256 + wr * 64 + (ln >> 3)) * DM + u.pn * 256 + wc * 64 + (ln & 7) * 8;
        u32x4 xl[4][2], res[4][2];
#pragma unroll
        for (int m = 0; m < 4; ++m) { xl[m][0] = *(const u32x4*)(sbase + (size_t)(m * 16) * DM); xl[m][1] = *(const u32x4*)(sbase + (size_t)(m * 16 + 8) * DM); }
#pragma unroll
        for (int ai = 0; ai < 2; ++ai) {
#pragma unroll
            for (int m = 0; m < 4; ++m) {
                *(PG8_LAS u32x4*)(my + (ln >> 3) * 144 + (ln & 7) * 16) = xl[m][0]; *(PG8_LAS u32x4*)(my + ((ln >> 3) + 8) * 144 + (ln & 7) * 16) = xl[m][1];
#pragma unroll
                for (int bj = 0; bj < 2; ++bj) { const u32x4 x4 = *(const PG8_LAS u32x4*)(my + fr * 144 + bj * 64 + fq * 16);
                    const f32x4 a0 = acc[ai][bj][m][0], a1 = acc[ai][bj][m][1];
                    u32x4 w; w.x = pkh2(hlo(x4.x) + a0[0], hhi(x4.x) + a0[1]); w.y = pkh2(hlo(x4.y) + a0[2], hhi(x4.y) + a0[3]);
                    w.z = pkh2(hlo(x4.z) + a1[0], hhi(x4.z) + a1[1]); w.w = pkh2(hlo(x4.w) + a1[2], hhi(x4.w) + a1[3]); res[m][bj] = w; }
            }
            if (ai == 0) {
#pragma unroll
                for (int m = 0; m < 4; ++m) { xl[m][0] = *(const u32x4*)(sbase + (size_t)(128 + m * 16) * DM); xl[m][1] = *(const u32x4*)(sbase + (size_t)(128 + m * 16 + 8) * DM); }
            }
            asm volatile("" ::: "memory");
#pragma unroll
            for (int m = 0; m < 4; ++m) {
                *(PG8_LAS u32x4*)(my + fr * 144 + fq * 16) = res[m][0]; *(PG8_LAS u32x4*)(my + fr * 144 + 64 + fq * 16) = res[m][1];
                const u32x4 r0 = *(const PG8_LAS u32x4*)(my + (ln >> 3) * 144 + (ln & 7) * 16), r1 = *(const PG8_LAS u32x4*)(my + ((ln >> 3) + 8) * 144 + (ln & 7) * 16);
                bf16* gp = sbase + (size_t)(ai * 128 + m * 16) * DM;
                *(u32x4*)gp = r0; *(u32x4*)(gp + 8 * DM) = r1; }
            asm volatile("" ::: "memory");
        }
    }
};
struct EpiGate {
#ifndef GATE_PERM
#define GATE_PERM 1
#endif
    static constexpr bool PERM = (GATE_PERM != 0), AFTER_DRAIN = false, KPF = false;
    const bf16* ple; const bf16* xh; float* out; float* dup; PG8_LAS unsigned char* stg;
    __device__ __forceinline__ void operator()(const f32x4 (&acc)[2][2][4][2], const pg8::Unit& u, int wr, int wc, int fr, int fq) const {
        if constexpr (PERM) {
        PG8_LAS unsigned char* my = stg + (wr * 4 + wc) * 2304; const int ln = fq * 16 + fr;
        const size_t lbase = (size_t)(u.pm * 256 + wr * 64 + (ln >> 3)) * DM + u.pn * 256 + wc * 64 + (ln & 7) * 8;
        const size_t pbase_ = (size_t)(u.pm * 256 + wr * 64 + (ln >> 3)) * PLE_LDR + u.pn * 512 + wc * 128 + (ln & 7) * 8;
        u32x4 xl[4][2], pl[4][2]; f32x4 res[4][2][2];
#pragma unroll
        for (int m = 0; m < 4; ++m) { const size_t off = lbase + (size_t)(m * 16) * DM, poff = pbase_ + (size_t)(m * 16) * PLE_LDR;
            xl[m][0] = *(const u32x4*)(xh + off); xl[m][1] = *(const u32x4*)(xh + off + 8 * DM); pl[m][0] = *(const u32x4*)(ple + poff); pl[m][1] = *(const u32x4*)(ple + poff + 8 * PLE_LDR); }
#pragma unroll
        for (int ai = 0; ai < 2; ++ai) {
#pragma unroll
            for (int m = 0; m < 4; ++m) {
                u32x4 xw[2], pw[2];
                *(PG8_LAS u32x4*)(my + (ln >> 3) * 144 + (ln & 7) * 16) = xl[m][0]; *(PG8_LAS u32x4*)(my + ((ln >> 3) + 8) * 144 + (ln & 7) * 16) = xl[m][1];
                xw[0] = *(const PG8_LAS u32x4*)(my + fr * 144 + fq * 16); xw[1] = *(const PG8_LAS u32x4*)(my + fr * 144 + 64 + fq * 16);
                *(PG8_LAS u32x4*)(my + (ln >> 3) * 144 + (ln & 7) * 16) = pl[m][0]; *(PG8_LAS u32x4*)(my + ((ln >> 3) + 8) * 144 + (ln & 7) * 16) = pl[m][1];
                pw[0] = *(const PG8_LAS u32x4*)(my + fr * 144 + fq * 16); pw[1] = *(const PG8_LAS u32x4*)(my + fr * 144 + 64 + fq * 16);
#pragma unroll
                for (int bj = 0; bj < 2; ++bj) {
                    const f32x4 a0 = acc[ai][bj][m][0], a1 = acc[ai][bj][m][1]; const u32x4 p4 = pw[bj], x4 = xw[bj];
                    f32x4 o0, o1;
                    o0[0] = hlo(x4.x) + bflo(p4.x) * sigmoidf_(a0[0]); o0[1] = hhi(x4.x) + bfhi(p4.x) * sigmoidf_(a0[1]);
                    o0[2] = hlo(x4.y) + bflo(p4.y) * sigmoidf_(a0[2]); o0[3] = hhi(x4.y) + bfhi(p4.y) * sigmoidf_(a0[3]);
                    o1[0] = hlo(x4.z) + bflo(p4.z) * sigmoidf_(a1[0]); o1[1] = hhi(x4.z) + bfhi(p4.z) * sigmoidf_(a1[1]);
                    o1[2] = hlo(x4.w) + bflo(p4.w) * sigmoidf_(a1[2]); o1[3] = hhi(x4.w) + bfhi(p4.w) * sigmoidf_(a1[3]);
                    res[m][bj][0] = o0; res[m][bj][1] = o1; }
            }
            if (ai == 0) {
#pragma unroll
                for (int m = 0; m < 4; ++m) { const size_t off = lbase + (size_t)(128 + m * 16) * DM, poff = pbase_ + (size_t)(128 + m * 16) * PLE_LDR;
                    xl[m][0] = *(const u32x4*)(xh + off); xl[m][1] = *(const u32x4*)(xh + off + 8 * DM); pl[m][0] = *(const u32x4*)(ple + poff); pl[m][1] = *(const u32x4*)(ple + poff + 8 * PLE_LDR); }
            }
            asm volatile("" ::: "memory");
#pragma unroll
            for (int m = 0; m < 4; ++m)
#pragma unroll
                for (int bj = 0; bj < 2; ++bj) {
                    *(PG8_LAS f32x4*)(my + fr * 144 + fq * 32) = res[m][bj][0]; *(PG8_LAS f32x4*)(my + fr * 144 + fq * 32 + 16) = res[m][bj][1];
                    const f32x4 r0 = *(const PG8_LAS f32x4*)(my + (ln >> 3) * 144 + (ln & 7) * 16), r1 = *(const PG8_LAS f32x4*)(my + ((ln >> 3) + 8) * 144 + (ln & 7) * 16);
                    float* gp = out + (size_t)(u.pm * 256 + ai * 128 + wr * 64 + m * 16 + (ln >> 3)) * DM + u.pn * 256 + wc * 64 + bj * 32 + (ln & 7) * 4;
                    *(f32x4*)gp = r0; *(f32x4*)(gp + 8 * DM) = r1; }
            asm volatile("" ::: "memory");
        }
        } else {
        const int row0 = u.pm * 256 + wr * 64 + fr, col0 = u.pn * 256 + wc * 32 + 4 * fq;
        float* obase = out + (size_t)row0 * DM + col0; const bf16* hbase = xh + (size_t)row0 * DM + col0; const bf16* pbase = ple + (size_t)row0 * DM + col0;
#pragma unroll
        for (int ai = 0; ai < 2; ++ai) {
            u32x2 xw[4][2][2], pw[4][2][2];
#pragma unroll
            for (int m = 0; m < 4; ++m)
#pragma unroll
                for (int bj = 0; bj < 2; ++bj)
#pragma unroll
                    for (int n = 0; n < 2; ++n) { const size_t off = (size_t)(ai * 128 + m * 16) * DM + bj * 128 + n * 16; xw[m][bj][n] = *(const u32x2*)(hbase + off); pw[m][bj][n] = *(const u32x2*)(pbase + off); }
#pragma unroll
            for (int m = 0; m < 4; ++m)
#pragma unroll
                for (int bj = 0; bj < 2; ++bj)
#pragma unroll
                    for (int n = 0; n < 2; ++n) { const size_t off = (size_t)(ai * 128 + m * 16) * DM + bj * 128 + n * 16;
                        const f32x4 a0 = acc[ai][bj][m][n]; const u32x2 p2 = pw[m][bj][n], x2 = xw[m][bj][n];
                        f32x4 o0;
                        o0[0] = hlo(x2.x) + bflo(p2.x) * sigmoidf_(a0[0]); o0[1] = hhi(x2.x) + bfhi(p2.x) * sigmoidf_(a0[1]);
                        o0[2] = hlo(x2.y) + bflo(p2.y) * sigmoidf_(a0[2]); o0[3] = hhi(x2.y) + bfhi(p2.y) * sigmoidf_(a0[3]);
                        *(f32x4*)(obase + off) = o0; }
            asm volatile("" ::: "memory");
        }
        }
    }
};

template <bool F16 = false> __device__ __forceinline__ void transpose_item(const float* W, int K, int N, bf16* WT, int k0, int n0, int dst_row0, LAS float* scr, int lane, const float* kscale = nullptr) {
    float wv[32];
#pragma unroll
    for (int i = 0; i < 32; ++i) { const int kk = 2 * i + (lane >> 5); wv[i] = W[(size_t)(k0 + kk) * N + n0 + (lane & 31)]; }
    if (kscale) {
#pragma unroll
        for (int i = 0; i < 32; ++i) wv[i] *= kscale[k0 + 2 * i + (lane >> 5)]; }
#pragma unroll
    for (int i = 0; i < 32; ++i) { const int kk = 2 * i + (lane >> 5); scr[kk * 33 + (lane & 31)] = wv[i]; }
    asm volatile("s_waitcnt lgkmcnt(0)" ::: "memory");
    const int c = lane & 7;
#pragma unroll
    for (int j = 0; j < 4; ++j) { const int n = (lane >> 3) + 8 * j; const LAS float* s = scr + (8 * c) * 33 + n;
        u32x4 o;
        if constexpr (F16) { o.x = pkh2(s[0 * 33], s[1 * 33]); o.y = pkh2(s[2 * 33], s[3 * 33]); o.z = pkh2(s[4 * 33], s[5 * 33]); o.w = pkh2(s[6 * 33], s[7 * 33]); }
        else { o.x = pk2(s[0 * 33], s[1 * 33]); o.y = pk2(s[2 * 33], s[3 * 33]); o.z = pk2(s[4 * 33], s[5 * 33]); o.w = pk2(s[6 * 33], s[7 * 33]); }
        *(u32x4*)(WT + (size_t)(dst_row0 + n) * K + k0 + 8 * c) = o; }
    asm volatile("s_waitcnt lgkmcnt(0)" ::: "memory");
}
__device__ __forceinline__ float wave_sum(float v) {
#pragma unroll
    for (int o = 1; o < 64; o <<= 1) v += __shfl_xor(v, o);
    return v;
}

__device__ __forceinline__ int grp_row0(int n0) { const int ga = (n0 & 255) >> 5; return (n0 & ~255) + 32 * (4 * (ga & 1) + (ga >> 1)); }
struct Params {
    const float* xp; const float* xs; const float* pp; const float* ps; const float* norm_w; const float* w_in;
    const float* qna; const float* kna; const float* sink; const float* qnb; const float* knb; const float* rpb;
    const float* w_out; const float* w_ple; const float* w_gate; float* out; unsigned char* ws;
    int ph_lo, ph_hi;
};

__device__ __forceinline__ void prologue(const Params& a, LAS unsigned char* lds, int tid, int lane, int wave, int G) {
    LAS float* scr = (LAS float*)(lds + wave * 16384);
    const int gw = blockIdx.x * NWAVES + wave, NGW = G * NWAVES;
    bf16* win_t = (bf16*)(a.ws + WS_WIN); bf16* wout_t = (bf16*)(a.ws + WS_WOUT); bf16* wgate_t = (bf16*)(a.ws + WS_WGATE); bf16* wple_t = (bf16*)(a.ws + WS_WPLE);
    constexpr int I_IN = (DM / 64) * (NIN / 32), I_SQ = (DM / 64) * (DM / 32), I_PLE = (PLE / 64) * (DM / 32);
    constexpr int NITEMS = I_IN + 2 * I_SQ + I_PLE;
    for (int it = gw; it < NITEMS; it += NGW) {
        int r = it;
        if (r < I_IN) { const int nblk = NIN / 32, kb = r / nblk, nb = r % nblk; const int n0 = 32 * nb; const int ga = (n0 & 255) >> 5, gl = 4 * (ga & 1) + (ga >> 1);
            transpose_item<true>(a.w_in, DM, NIN, win_t, 64 * kb, n0, (n0 & ~255) + 32 * gl, scr, lane, a.norm_w); continue; }
        r -= I_IN;
        if (r < I_SQ) { const int kb = r / 32, nb = r % 32; transpose_item(a.w_out, DM, DM, wout_t, 64 * kb, 32 * nb, grp_row0(32 * nb), scr, lane); continue; }
        r -= I_SQ;
        if (r < I_SQ) { const int kb = r / 32, nb = r % 32; transpose_item<true>(a.w_gate, DM, DM, wgate_t, 64 * kb, 32 * nb, grp_row0(32 * nb), scr, lane); continue; }
        r -= I_SQ;
        { const int kb = r / 32, nb = r % 32; transpose_item(a.w_ple, PLE, DM, wple_t, 64 * kb, 32 * nb, grp_row0(32 * nb), scr, lane); }
    }
    {
        float* rope = (float*)(a.ws + WS_ROPE);
        const double inv_freq[8] = {1.0, 0.19392274474868576, 0.03760603093086393, 0.007292664737217109, 0.001414213562373095, 0.0002742481756762073, 5.318295896944988e-05, 1.031338537721246e-05};
        for (int e = blockIdx.x * NTHREADS + tid; e < SEQ * 8; e += G * NTHREADS) {
            const int pos = e >> 3, i = e & 7;
            double f = 1.0;
#pragma unroll
            for (int k = 0; k < 8; ++k) f = (i == k) ? inv_freq[k] : f;
            double t = (double)pos * f * 0.15915494309189535; t -= __builtin_floor(t);
            const float tf = (float)t;
            rope[pos * 16 + i] = __builtin_amdgcn_cosf(tf); rope[pos * 16 + 8 + i] = __builtin_amdgcn_sinf(tf);
        }
    }
    {
        bf16* xh = (bf16*)(a.ws + WS_XN); float* rinv = (float*)(a.ws + WS_RINV);
        constexpr int RB = 4;
#define P0_ROW(M0, r) (gw + P0_PERM(((M0) - gw) / NGW + (r)) * NGW)
#define P0_PERM(tb) (permute ? (5 * ((tb) & 7) + 4 - ((tb) >> 3)) : (tb))
#define P0_LOAD(V, M0) do { _Pragma("unroll") for (int r = 0; r < RB; ++r) { const int m = ((M0) + r * NGW < MTOK) ? P0_ROW(M0, r) : MTOK; \
            if (m < MTOK) { const float* xrow = (m < MPROMPT) ? a.xp + (size_t)m * DM : a.xs + (size_t)(m - MPROMPT) * DM; const f32x4* xr = (const f32x4*)xrow + lane; \
                _Pragma("unroll") for (int j = 0; j < 4; ++j) V[r][j] = xr[64 * j]; } } } while (0)
#define P0_PROC(V, M0) do { _Pragma("unroll") for (int r = 0; r < RB; ++r) { const int m = ((M0) + r * NGW < MTOK) ? P0_ROW(M0, r) : MTOK; \
            if (m < MTOK) { float ss = 0.f; \
                _Pragma("unroll") for (int j = 0; j < 4; ++j) ss += (V[r][j][0] * V[r][j][0] + V[r][j][1] * V[r][j][1]) + (V[r][j][2] * V[r][j][2] + V[r][j][3] * V[r][j][3]); \
                ss = wave_sum(ss); \
                if (lane == 0) rinv[m] = 1.0f / sqrtf(ss * (1.0f / DM) + EPS); \
                u32x2* o8 = (u32x2*)(xh + (size_t)m * DM) + lane; \
                _Pragma("unroll") for (int j = 0; j < 4; ++j) { u32x2 w2; w2.x = pkh2(V[r][j][0], V[r][j][1]); w2.y = pkh2(V[r][j][2], V[r][j][3]); o8[64 * j] = w2; } } } } while (0)
        f32x4 va[RB][4], vb[RB][4];
        const bool permute = (NGW == SEQ);
        const int step = RB * NGW;
        P0_LOAD(va, gw);
        for (int m0 = gw; m0 < MTOK; m0 += 2 * step) {
            P0_LOAD(vb, m0 + step);
            asm volatile("" ::: "memory");
            P0_PROC(va, m0);
            asm volatile("" ::: "memory");
            P0_LOAD(va, m0 + 2 * step);
            asm volatile("" ::: "memory");
            P0_PROC(vb, m0 + step);
            asm volatile("" ::: "memory");
        }
#undef P0_LOAD
#undef P0_PROC
#undef P0_ROW
#undef P0_PERM
    }
    {
        bf16* pbf = (bf16*)(a.ws + WS_PBF);
        const size_t n4 = (size_t)MTOK * PLE / 4, np4 = (size_t)MPROMPT * PLE / 4, stride = (size_t)G * NTHREADS;
#define PB_LOAD(V, E0) do { _Pragma("unroll") for (int r = 0; r < 4; ++r) { const size_t e = (E0) + r * stride; if (e < n4) V[r] = (e < np4) ? ((const f32x4*)a.pp)[e] : ((const f32x4*)a.ps)[e - np4]; } } while (0)
#define PB_STORE(V, E0) do { _Pragma("unroll") for (int r = 0; r < 4; ++r) { const size_t e = (E0) + r * stride; if (e < n4) { u32x2 w2; w2.x = pk2(V[r][0], V[r][1]); w2.y = pk2(V[r][2], V[r][3]); ((u32x2*)pbf)[e] = w2; } } } while (0)
        f32x4 pa[4], pb[4];
        const size_t e00 = (size_t)blockIdx.x * NTHREADS + tid;
        PB_LOAD(pa, e00);
        for (size_t e0 = e00; e0 < n4; e0 += 8 * stride) {
            PB_LOAD(pb, e0 + 4 * stride);
            asm volatile("" ::: "memory");
            PB_STORE(pa, e0);
            asm volatile("" ::: "memory");
            PB_LOAD(pa, e0 + 8 * stride);
            asm volatile("" ::: "memory");
            PB_STORE(pb, e0 + 4 * stride);
            asm volatile("" ::: "memory");
        }
#undef PB_LOAD
#undef PB_STORE
    }
}

constexpr int KP = 144, VP = 160;
typedef short v4i16_t __attribute__((ext_vector_type(4)));
__device__ __forceinline__ s16x4 tr_read(const LAS unsigned char* p) { return __builtin_bit_cast(s16x4, __builtin_amdgcn_ds_read_tr16_b64_v4i16((LAS v4i16_t*)p)); }
__device__ __forceinline__ f32x4 mfma16(bf16x8 a, bf16x8 b, f32x4 c) { return __builtin_amdgcn_mfma_f32_16x16x32_bf16(a, b, c, 0, 0, 0); }

template <int NT, int VPITCH> __device__ __forceinline__ void softmax_pv_store(float (&S)[NT][4], float sink_term_valid, float sinkv, const LAS unsigned char* Vs, int vrow0, const int (&vrow)[(NT + 1) / 2],
                                                                   const u32x2 (&gatev)[4], bf16* out_ptr, int i16, int g) {
    float m = sink_term_valid != 0.f ? sinkv : -INFINITY;
#pragma unroll
    for (int t = 0; t < NT; ++t)
#pragma unroll
        for (int r = 0; r < 4; ++r) m = fmaxf(m, S[t][r]);
    m = fmaxf(m, __shfl_xor(m, 16)); m = fmaxf(m, __shfl_xor(m, 32));
    const float mb = m * L2E;
#pragma unroll
    for (int t = 0; t < NT; ++t)
#pragma unroll
        for (int r = 0; r < 4; ++r) S[t][r] = fast_exp2(S[t][r] * L2E - mb);
    f32x4 lsum = (f32x4){0.f, 0.f, 0.f, 0.f};
    const bf16x8 ones = (bf16x8){0x3f80, 0x3f80, 0x3f80, 0x3f80, 0x3f80, 0x3f80, 0x3f80, 0x3f80};
    f32x4 o[4];
#pragma unroll
    for (int dt = 0; dt < 4; ++dt) o[dt] = (f32x4){0.f, 0.f, 0.f, 0.f};
    const LAS unsigned char* vb = Vs + (vrow0 + 4 * g + (i16 >> 2)) * VPITCH + (i16 & 3) * 8;
    constexpr int NS = (NT + 1) / 2;
#pragma unroll
    for (int s = 0; s < NS; ++s) {
        u32x4 pw; pw.x = pk2(S[2 * s][0], S[2 * s][1]); pw.y = pk2(S[2 * s][2], S[2 * s][3]);
        if (2 * s + 1 < NT) { pw.z = pk2(S[(2 * s + 1) < NT ? 2 * s + 1 : 0][0], S[(2 * s + 1) < NT ? 2 * s + 1 : 0][1]); pw.w = pk2(S[(2 * s + 1) < NT ? 2 * s + 1 : 0][2], S[(2 * s + 1) < NT ? 2 * s + 1 : 0][3]); }
        else { pw.z = 0u; pw.w = 0u; }
        const bf16x8 pf = __builtin_bit_cast(bf16x8, pw);
#pragma unroll
        for (int dt = 0; dt < 4; ++dt) {
            const s16x4 lo = tr_read(vb + vrow[s] * VPITCH + dt * 32), hi = tr_read(vb + (vrow[s] + 16) * VPITCH + dt * 32);
            const bf16x8 vf = (bf16x8){lo[0], lo[1], lo[2], lo[3], hi[0], hi[1], hi[2], hi[3]};
            o[dt] = mfma16(vf, pf, o[dt]);
        }
        lsum = mfma16(ones, pf, lsum);
    }
    float l = lsum[0];
    if (sink_term_valid != 0.f) l += fast_exp2(sinkv * L2E - mb);
    const float inv = 1.0f / l;
#pragma unroll
    for (int dt = 0; dt < 4; ++dt) {
        const u32x2 gw = gatev[dt];
        u32x2 w2; w2.x = pk2(o[dt][0] * inv * bflo(gw.x), o[dt][1] * inv * bfhi(gw.x)); w2.y = pk2(o[dt][2] * inv * bflo(gw.y), o[dt][3] * inv * bfhi(gw.y));
        *(u32x2*)(out_ptr + dt * 16 + 4 * g) = w2;
    }
}

struct PfA { u32x4 k[7], v[7]; };
__device__ __forceinline__ void attnA_fetch(PfA& pf, const bf16* KA, const bf16* VA, int u, int tid) {
    const int kh = (u >> 3) & 1, j = (u >> 4) & 15, b = 5 * (u & 7) + 4 - (u >> 8), span0 = j * 128 - 128;
#pragma unroll
    for (int i = 0; i < 7; ++i) {
        const int c = tid + NTHREADS * i, row = c >> 3, ch = c & 7, kpos = span0 + row;
        pf.k[i] = (u32x4){0u, 0u, 0u, 0u}; pf.v[i] = (u32x4){0u, 0u, 0u, 0u};
        if (row < 384 && kpos >= 0 && kpos < SEQ) { const size_t o = ((size_t)(b * 2 + kh) * SEQ + kpos) * 64 + ch * 8; pf.k[i] = *(const u32x4*)(KA + o); pf.v[i] = *(const u32x4*)(VA + o); }
    }
}
__device__ __forceinline__ void attnA_commit(const PfA& pf, LAS unsigned char* lds, int tid) {
    LAS unsigned char* Ks = lds; LAS unsigned char* Vs = lds + 384 * KP;
#pragma unroll
    for (int i = 0; i < 7; ++i) {
        const int c = tid + NTHREADS * i, row = c >> 3, ch = c & 7;
        if (row < 384) *(LAS u32x4*)(Ks + row * KP + ch * 16) = pf.k[i];
        if (row < 400) *(LAS u32x4*)(Vs + row * VP + ch * 16) = pf.v[i];
    }
}
__device__ __forceinline__ void attnA_first(const bf16* proj, int u, int lane, int wave, bf16x8& qn0, bf16x8& qn1, u32x2 (&gnext)[4]) {
    const int kh = (u >> 3) & 1, j = (u >> 4) & 15, b = 5 * (u & 7) + 4 - (u >> 8); const int i16 = lane & 15, g = lane >> 4, head = kh * 4 + (wave >> 1);
    const size_t tok0 = (size_t)b * SEQ + j * 128 + (wave & 1) * 64 + i16; const bf16* qp = proj + tok0 * NPJ + C_QA + head * 64 + g * 8;
    qn0 = *(const bf16x8*)(qp); qn1 = *(const bf16x8*)(qp + 32);
#pragma unroll
    for (int dt = 0; dt < 4; ++dt) gnext[dt] = *(const u32x2*)(proj + tok0 * NPJ + C_GA + head * 64 + dt * 16 + 4 * g);
}
template <bool EDGE> __device__ __forceinline__ void attnA_compute(LAS unsigned char* lds, const bf16* proj, bf16* mix, const float* sink, int u, int lane, int wave, bf16x8 qn0, bf16x8 qn1, u32x2 (&gnext)[4]) {
    const int kh = (u >> 3) & 1, j = (u >> 4) & 15, b = 5 * (u & 7) + 4 - (u >> 8);
    const LAS unsigned char* Ks = lds; const LAS unsigned char* Vs = lds + 384 * KP;
    const int i16 = lane & 15, g = lane >> 4;
    const int head = kh * 4 + (wave >> 1);
    const float sinkv = sink[head];
#pragma unroll
    for (int i = 0; i < 4; ++i) {
        const int qt = (wave & 1) * 4 + i, q0 = j * 128 + qt * 16;
        const size_t tokq = (size_t)b * SEQ + q0 + i16;
        u32x2 gatev[4];
#pragma unroll
        for (int dt = 0; dt < 4; ++dt) gatev[dt] = gnext[dt];
        const bf16x8 qf0 = qn0, qf1 = qn1;
        float S[17][4];
        const LAS unsigned char* kb = Ks + (qt * 16 + i16) * KP + g * 16;
#pragma unroll
        for (int t = 0; t < 17; ++t) {
            const int kpos0 = q0 - 128 + 16 * t;
            if (!EDGE || (kpos0 >= 0 && kpos0 < SEQ)) {
                f32x4 acc = (f32x4){0.f, 0.f, 0.f, 0.f};
                acc = mfma16(*(const LAS bf16x8*)(kb + 16 * t * KP), qf0, acc);
                acc = mfma16(*(const LAS bf16x8*)(kb + 16 * t * KP + 64), qf1, acc);
#pragma unroll
                for (int r = 0; r < 4; ++r) S[t][r] = acc[r];
            } else {
#pragma unroll
                for (int r = 0; r < 4; ++r) S[t][r] = -INFINITY;
            }
        }
#pragma unroll
        for (int r = 0; r < 4; ++r) { if (4 * g + r < i16) S[0][r] = -INFINITY; if (4 * g + r > i16) S[16][r] = -INFINITY; }
        if (i < 3) { const bf16* qp = proj + (tokq + 16) * NPJ + C_QA + head * 64 + g * 8; qn0 = *(const bf16x8*)(qp); qn1 = *(const bf16x8*)(qp + 32);
#pragma unroll
            for (int dt = 0; dt < 4; ++dt) gnext[dt] = *(const u32x2*)(proj + (tokq + 16) * NPJ + C_GA + head * 64 + dt * 16 + 4 * g); }
        int vrow[9];
#pragma unroll
        for (int ks = 0; ks < 9; ++ks) vrow[ks] = 32 * ks;
        softmax_pv_store<17, VP>(S, 1.f, sinkv, Vs, qt * 16, vrow, gatev, mix + tokq * DM + head * 64, i16, g);
    }
}

__device__ __forceinline__ int clampi(int v, int lo, int hi) { return v < lo ? lo : (v > hi ? hi : v); }
constexpr int VPB = 144;
constexpr int B_RROWS = 512, B_VOFF = B_RROWS * KP, B_TOFF = B_VOFF + B_RROWS * VPB;
static_assert(B_TOFF + 2048 <= LDS_BYTES - 64 && 384 * KP + 400 * VP <= LDS_BYTES - 64, "LDS map");
struct PfB { u32x4 k[6], v[6]; float bias; bf16x8 q0, q1; u32x2 gate[4]; };
__device__ __forceinline__ void attnB_fetch(PfB& pf, const bf16* proj, const bf16* KB, const bf16* VB, const float* rpb, int w, int R, int tid) {
    const int n = (w >> 3) & 3, h = (w >> 5) & 7, b = 5 * (w & 7) + 4 - (w >> 8);
    const int nlo = (R == 0) ? 0 : (R == 1) ? 11 : (R == 2) ? 19 : 27, ncnt = (R == 0) ? 11 : (R == 3) ? 5 : 8;
    const int blk = clampi(16 * n - 8, 0, 32);
#pragma unroll
    for (int i = 0; i < 6; ++i) {
        const int c = tid + NTHREADS * i, rowi = c >> 8, kcol = (c >> 3) & 31, ch = c & 7;
        pf.k[i] = (u32x4){0u, 0u, 0u, 0u}; pf.v[i] = (u32x4){0u, 0u, 0u, 0u};
        if (rowi < ncnt) { const size_t o = ((size_t)(b * 8 + h) * SEQ + (nlo + rowi) * 64 + blk + kcol) * 64 + ch * 8; pf.k[i] = *(const u32x4*)(KB + o); pf.v[i] = *(const u32x4*)(VB + o); }
    }
    { const int idx = tid - 16; pf.bias = (idx >= 0 && idx < 465) ? rpb[h * 465 + idx] : 0.f; }
    { const int lane = tid & 63, wave = tid >> 6; const size_t tokq = (size_t)b * SEQ + (8 * R + wave) * 64 + 16 * n + (lane & 15);
      const bf16* qp = proj + tokq * NPJ + C_QB + h * 64 + (lane >> 4) * 8; pf.q0 = *(const bf16x8*)(qp); pf.q1 = *(const bf16x8*)(qp + 32);
#pragma unroll
      for (int dt = 0; dt < 4; ++dt) pf.gate[dt] = *(const u32x2*)(proj + tokq * NPJ + C_GB + h * 64 + dt * 16 + 4 * (lane >> 4)); }
}
__device__ __forceinline__ void attnB_commit(const PfB& pf, LAS unsigned char* lds, int R, int tid) {
    LAS unsigned char* Ks = lds; LAS unsigned char* Vs = lds + B_VOFF; LAS float* tbl = (LAS float*)(lds + B_TOFF);
    const int nlo = (R == 0) ? 0 : (R == 1) ? 11 : (R == 2) ? 19 : 27, ncnt = (R == 0) ? 11 : (R == 3) ? 5 : 8;
#pragma unroll
    for (int i = 0; i < 6; ++i) {
        const int c = tid + NTHREADS * i, rowi = c >> 8, kcol = (c >> 3) & 31, ch = c & 7;
        if (rowi < ncnt) { const int row = ((nlo + rowi) & 15) * 32 + kcol; *(LAS u32x4*)(Ks + row * KP + ch * 16) = pf.k[i]; *(LAS u32x4*)(Vs + row * VPB + ch * 16) = pf.v[i]; }
    }
    if (R == 0) tbl[tid] = pf.bias;
}
__device__ __forceinline__ void attnB_compute(LAS unsigned char* lds, bf16* mix, int w, int R, bf16x8 qf0, bf16x8 qf1, const u32x2 (&gatev)[4], int lane, int wave) {
    const int n = (w >> 3) & 3, h = (w >> 5) & 7, b = 5 * (w & 7) + 4 - (w >> 8);
    const LAS unsigned char* Ks = lds; const LAS unsigned char* Vs = lds + B_VOFF; const LAS float* tbl = (const LAS float*)(lds + B_TOFF);
    const int blk = clampi(16 * n - 8, 0, 32);
    const int i16 = lane & 15, g = lane >> 4;
    const int r = 8 * R + wave, rs = clampi(r - 4, 0, 24), c = 16 * n + i16, cs = clampi(c - 8, 0, 48);
    const size_t tokq = (size_t)b * SEQ + r * 64 + c;
    int vrow[8];
#pragma unroll
    for (int a = 0; a < 8; ++a) vrow[a] = ((rs + a) & 15) * 32;
    const int wloc = cs - blk;
    bool v0[4]; unsigned m01, m23;
#pragma unroll
    for (int rr = 0; rr < 4; ++rr) v0[rr] = (4 * g + rr) >= wloc;
    m01 = (v0[0] ? 0xffffu : 0u) | (v0[1] ? 0xffff0000u : 0u); m23 = (v0[2] ? 0xffffu : 0u) | (v0[3] ? 0xffff0000u : 0u);
    float Sm[8][4];
    const LAS unsigned char* kb = Ks + i16 * KP + g * 16;
    const LAS float* tb = tbl + 16 + (rs - r + 7) * 31 + (blk + 4 * g - c + 15);
#pragma unroll
    for (int a = 0; a < 8; ++a) {
        f32x4 acc0 = (f32x4){tb[a * 31 + 0], tb[a * 31 + 1], tb[a * 31 + 2], tb[a * 31 + 3]};
        f32x4 acc1 = (f32x4){tb[a * 31 + 16], tb[a * 31 + 17], tb[a * 31 + 18], tb[a * 31 + 19]};
        acc0 = mfma16(*(const LAS bf16x8*)(kb + vrow[a] * KP), qf0, acc0);
        acc0 = mfma16(*(const LAS bf16x8*)(kb + vrow[a] * KP + 64), qf1, acc0);
        acc1 = mfma16(*(const LAS bf16x8*)(kb + (vrow[a] + 16) * KP), qf0, acc1);
        acc1 = mfma16(*(const LAS bf16x8*)(kb + (vrow[a] + 16) * KP + 64), qf1, acc1);
#pragma unroll
        for (int rr = 0; rr < 4; ++rr) Sm[a][rr] = v0[rr] ? acc0[rr] : acc1[rr];
    }
    float m = -INFINITY;
#pragma unroll
    for (int a = 0; a < 8; ++a)
#pragma unroll
        for (int rr = 0; rr < 4; ++rr) m = fmaxf(m, Sm[a][rr]);
    m = fmaxf(m, __shfl_xor(m, 16)); m = fmaxf(m, __shfl_xor(m, 32));
    const float mb = m * L2E;
#pragma unroll
    for (int a = 0; a < 8; ++a)
#pragma unroll
        for (int rr = 0; rr < 4; ++rr) Sm[a][rr] = fast_exp2(Sm[a][rr] * L2E - mb);
    f32x4 lsum = (f32x4){0.f, 0.f, 0.f, 0.f};
    const bf16x8 ones = (bf16x8){0x3f80, 0x3f80, 0x3f80, 0x3f80, 0x3f80, 0x3f80, 0x3f80, 0x3f80};
    f32x4 o[4];
#pragma unroll
    for (int dt = 0; dt < 4; ++dt) o[dt] = (f32x4){0.f, 0.f, 0.f, 0.f};
    const LAS unsigned char* vb = Vs + (4 * g + (i16 >> 2)) * VPB + (i16 & 3) * 8;
#pragma unroll
    for (int a = 0; a < 8; ++a) {
        const unsigned p01 = pk2(Sm[a][0], Sm[a][1]), p23 = pk2(Sm[a][2], Sm[a][3]);
        u32x4 pw; pw.x = p01 & m01; pw.y = p23 & m23; pw.z = p01 & ~m01; pw.w = p23 & ~m23;
        const bf16x8 pf = __builtin_bit_cast(bf16x8, pw);
#pragma unroll
        for (int dt = 0; dt < 4; ++dt) {
            const s16x4 lo = tr_read(vb + vrow[a] * VPB + dt * 32), hi = tr_read(vb + (vrow[a] + 16) * VPB + dt * 32);
            const bf16x8 vf = (bf16x8){lo[0], lo[1], lo[2], lo[3], hi[0], hi[1], hi[2], hi[3]};
            o[dt] = mfma16(vf, pf, o[dt]);
        }
        lsum = mfma16(ones, pf, lsum);
    }
    const float inv = 1.0f / lsum[0];
    bf16* out_ptr = mix + tokq * DM + 512 + h * 64;
#pragma unroll
    for (int dt = 0; dt < 4; ++dt) {
        const u32x2 gw = gatev[dt];
        u32x2 w2; w2.x = pk2(o[dt][0] * inv * bflo(gw.x), o[dt][1] * inv * bfhi(gw.x)); w2.y = pk2(o[dt][2] * inv * bflo(gw.y), o[dt][3] * inv * bfhi(gw.y));
        *(u32x2*)(out_ptr + dt * 16 + 4 * g) = w2;
    }
}
__device__ __forceinline__ void attention_phase(LAS unsigned char* lds, const bf16* proj, const bf16* KA, const bf16* VA, const bf16* KB, const bf16* VB, bf16* mix, const float* sink, const float* rpb, int G, int tid, int lane, int wave) {
    constexpr int NA = NBATCH * 16 * 2, NBU = NBATCH * 8 * 4 * 4;
#ifndef REPA
#define REPA 1
#endif
#ifndef REPB
#define REPB 1
#endif
    for (int repa = 0; repa < REPA; ++repa) {
        int u = blockIdx.x; PfA pf;
        if (u < NA) attnA_fetch(pf, KA, VA, u, tid);
        for (; u < NA; u += G) {
            attnA_commit(pf, lds, tid);
            __syncthreads();
            bf16x8 qn0, qn1; u32x2 gfirst[4]; attnA_first(proj, u, lane, wave, qn0, qn1, gfirst);
            if (u + G < NA) attnA_fetch(pf, KA, VA, u + G, tid);
            { const int jj = (u >> 4) & 15; if (jj == 0 || jj == 15) attnA_compute<true>(lds, proj, mix, sink, u, lane, wave, qn0, qn1, gfirst); else attnA_compute<false>(lds, proj, mix, sink, u, lane, wave, qn0, qn1, gfirst); }
            __syncthreads();
        }
    }
    for (int repb = 0; repb < REPB; ++repb) {
        constexpr int NW = NBATCH * 8 * 4;
        int w = blockIdx.x, R = 0; PfB pf;
        if (w < NW) attnB_fetch(pf, proj, KB, VB, rpb, w, 0, tid);
        while (w < NW) {
            attnB_commit(pf, lds, R, tid);
            const bf16x8 qf0 = pf.q0, qf1 = pf.q1; u32x2 gatev[4];
#pragma unroll
            for (int dt = 0; dt < 4; ++dt) gatev[dt] = pf.gate[dt];
            __syncthreads();
            const int wn = (R == 3) ? w + G : w, Rn = (R + 1) & 3;
            if (wn < NW) attnB_fetch(pf, proj, KB, VB, rpb, wn, Rn, tid);
            attnB_compute(lds, mix, w, R, qf0, qf1, gatev, lane, wave);
            __syncthreads();
            w = wn; R = Rn;
        }
    }
}

#define XB_TMO      128
#define XB_XCNT(j)  (256  + 64 * (j))
#define XB_XSUB(j)  (1280 + 64 * (j))
#define XB_XGEN(j)  (2304 + 64 * (j))
#define XB_TOP      3328
#define XB_TOPGEN   3392
#define XCD_BAR_WORDS 3456
#define XB_SPIN_CAP (1u << 18)

__device__ __forceinline__ unsigned xb_ld(unsigned* p)              { return __hip_atomic_load(p, __ATOMIC_RELAXED, __HIP_MEMORY_SCOPE_AGENT); }
__device__ __forceinline__ unsigned xb_add(unsigned* p, unsigned v) { return __hip_atomic_fetch_add(p, v, __ATOMIC_RELAXED, __HIP_MEMORY_SCOPE_AGENT); }
__device__ __forceinline__ unsigned xb_xcc_id() { return (unsigned)__builtin_amdgcn_s_getreg((3 << 11) | 20) & 0xFu; }
#define XB_SPIN(cond, bar) do { unsigned _sp = 0; while (cond) { __builtin_amdgcn_s_sleep(1); \
    if ((++_sp & 255u) == 0u) { if (xb_ld(&(bar)[XB_TMO])) break; if (_sp > XB_SPIN_CAP) { atomicAdd(&(bar)[XB_TMO], 1u); break; } } } } while (0)

struct XcdBarrier {
    unsigned* bar; unsigned x;
    volatile LAS unsigned* st;
};

__device__ __forceinline__ XcdBarrier xcd_barrier_post(unsigned* bar, volatile LAS unsigned* st) {
    XcdBarrier b; b.bar = bar; b.x = xb_xcc_id(); b.st = st;
    if (threadIdx.x == 0) (void)xb_add(&bar[XB_XCNT(b.x)], 1u);
    return b;
}
__device__ __forceinline__ void xcd_barrier_complete(unsigned* bar, unsigned x, unsigned& nloc, unsigned& nx) {
    const unsigned G = gridDim.x * gridDim.y * gridDim.z;
    unsigned sum, cnt, mine, sp = 0u;
    for (;;) {
        sum = 0u; cnt = 0u; mine = 0u;
#pragma unroll
        for (unsigned j = 0; j < 16; ++j) { const unsigned c = xb_ld(&bar[XB_XCNT(j)]); sum += c; cnt += (c > 0u) ? 1u : 0u; mine = (j == x) ? c : mine; }
        if (sum == G) break;
        __builtin_amdgcn_s_sleep(1);
        if ((++sp & 255u) == 0u) { if (xb_ld(&bar[XB_TMO])) break; if (sp > XB_SPIN_CAP) { atomicAdd(&bar[XB_TMO], 1u); break; } }
    }
    nloc = mine > 0u ? mine : 1u; nx = cnt > 0u ? cnt : 1u;
}

__device__ __forceinline__ void xcd_barrier(const XcdBarrier& b) {
    asm volatile("s_waitcnt vmcnt(0)" ::: "memory");
    __syncthreads();
    if (threadIdx.x == 0) {
        unsigned* bar = b.bar;
        __builtin_amdgcn_s_waitcnt(0);
        unsigned nloc = b.st[0], nx = b.st[1];
        if (nloc == 0u) { xcd_barrier_complete(bar, b.x, nloc, nx); b.st[0] = nloc; b.st[1] = nx; }
        const unsigned old = xb_add(&bar[XB_XSUB(b.x)], 1u);
        const unsigned gen = old / nloc;
        if (old + 1u == (gen + 1u) * nloc) {
            __builtin_amdgcn_fence(__ATOMIC_RELEASE, "agent");
            asm volatile("s_waitcnt vmcnt(0)" ::: "memory");
            const unsigned og = xb_add(&bar[XB_TOP], 1u);
            const unsigned tg = og / nx;
            if (og + 1u == (tg + 1u) * nx) xb_add(&bar[XB_TOPGEN], 1u);
            else XB_SPIN(xb_ld(&bar[XB_TOPGEN]) == tg, bar);
            __builtin_amdgcn_fence(__ATOMIC_ACQUIRE, "agent");
            xb_add(&bar[XB_XGEN(b.x)], 1u);
            asm volatile("s_waitcnt vmcnt(0)" ::: "memory");
        } else {
            XB_SPIN(xb_ld(&bar[XB_XGEN(b.x)]) == gen, bar);
            __builtin_amdgcn_fence(__ATOMIC_ACQUIRE, "agent");
            asm volatile("s_waitcnt vmcnt(0)" ::: "memory");
        }
    }
    __syncthreads();
}

struct PleOrder {
    int c, G, phase;
    __device__ __forceinline__ bool next(int i, pg8::Unit& u) const {
        int idx;
        if (G == 256) { if (phase == 0) { if (c < 64) return false; idx = (c - 64) + 192 * i; if (idx >= 520) return false; } else { idx = 520 + c + 256 * i; if (idx >= 1280) return false; } }
        else { if (phase == 0) return false; idx = c + G * i; if (idx >= 1280) return false; }
        { const int xcd = idx & 7, r = idx >> 3; u.pn = r & 3; u.pm = 8 * (r >> 2) + xcd; }
        return true;
    }
    __device__ __forceinline__ void a_ready(const pg8::Unit&) const {}
    __device__ __forceinline__ void done(const pg8::Unit&) const {}
};

__global__ void __launch_bounds__(NTHREADS, 2) enc_fwd(Params a) {
    extern __shared__ __attribute__((aligned(16))) unsigned char lds_raw[];
    LAS unsigned char* lds = (LAS unsigned char*)lds_raw;
    const int tid = threadIdx.x, lane = tid & 63, wave = __builtin_amdgcn_readfirstlane(tid >> 6);
    const int G = gridDim.x;
    cg::grid_group grid = cg::this_grid();
    volatile LAS unsigned* misc = (volatile LAS unsigned*)(lds + LDS_BYTES - 64);
    if (tid < 16) misc[tid] = 0u;
    __syncthreads();
    XcdBarrier xbar = xcd_barrier_post((unsigned*)(a.ws + WS_CTL), misc);
    if (a.ph_lo > 1000) grid.sync();
    unsigned char* ws = a.ws;
    bf16* xn = (bf16*)(ws + WS_XN); bf16* pbf = (bf16*)(ws + WS_PBF); bf16* proj = (bf16*)(ws + WS_PROJ); bf16* mix = (bf16*)(ws + WS_MIX); bf16* ple = (bf16*)a.out; float* x2f = (float*)(ws + WS_PROJ);
    const int lo = a.ph_lo, hi = a.ph_hi;
#ifdef PHASE_MASK
#define IN(k) (((PHASE_MASK >> (k)) & 1) && lo <= (k) && (k) < hi)
#else
#define IN(k) (lo <= (k) && (k) < hi)
#endif
#define SEAM(k) do { if (IN(k) && IN((k) + 1)) xcd_barrier(xbar); } while (0)
#ifndef GREP1
#define GREP1 1
#endif
#ifndef GREP3
#define GREP3 1
#endif
#ifndef GREP3B
#define GREP3B 1
#endif
#ifndef GREP4
#define GREP4 1
#endif
#ifndef REP0
#define REP0 1
#endif
#ifndef REP1
#define REP1 1
#endif
#ifndef REP2
#define REP2 1
#endif
#ifndef REP3
#define REP3 1
#endif
    if (IN(0)) for (int rep = 0; rep < REP0; ++rep) prologue(a, lds, tid, lane, wave, G);
    SEAM(0);
#ifdef XSYNC
    for (int q = 0; q < XSYNC; ++q) xcd_barrier(xbar);
#endif
    if (IN(1)) for (int rep = 0; rep < REP1; ++rep) {
        pg8::Gemm g{xn, (const bf16*)(ws + WS_WIN), MTOK, NIN, DM}; pg8::StaticOrder S; S.init(MTOK, NIN, G, (int)blockIdx.x); S.reps = GREP1;
        EpiProj E{lds + pg8::STAGE_BYTES, proj, (bf16*)(ws + WS_KA), (bf16*)(ws + WS_VA), (bf16*)(ws + WS_KB), (bf16*)(ws + WS_VB), (const float*)(ws + WS_RINV), a.qna, a.kna, a.qnb, a.knb, (const float*)(ws + WS_ROPE)};
#ifndef P1_SP2
#define P1_SP2 true
#endif
        pg8::gemm_phase<EpiProj, pg8::StaticOrder, true, P1_SP2, true>(lds, g, S, E);
        { pg8::Gemm gp{pbf, (const bf16*)(ws + WS_WPLE), MTOK, DM, PLE}; EpiPlain Ep{ple, DM, lds + pg8::STAGE_BYTES}; PleOrder SP{(int)blockIdx.x, G, 0};
          pg8::gemm_phase<EpiPlain, PleOrder, true, true>(lds, gp, SP, Ep); }
    }
    SEAM(1);
    if (IN(2)) for (int rep = 0; rep < REP2; ++rep) attention_phase(lds, proj, (const bf16*)(ws + WS_KA), (const bf16*)(ws + WS_VA), (const bf16*)(ws + WS_KB), (const bf16*)(ws + WS_VB), mix, a.sink, a.rpb, G, tid, lane, wave);
    if (IN(2)) { pg8::Gemm gp{pbf, (const bf16*)(ws + WS_WPLE), MTOK, DM, PLE}; EpiPlain Ep{ple, DM, lds + pg8::STAGE_BYTES}; PleOrder SP{(int)blockIdx.x, G, 1};
        __syncthreads();
        pg8::gemm_phase<EpiPlain, PleOrder, true, true>(lds, gp, SP, Ep); }
    SEAM(2);
    if (IN(3)) {
        { pg8::Gemm g{mix, (const bf16*)(ws + WS_WOUT), MTOK, DM, DM}; pg8::StaticOrder S; S.init(MTOK, DM, G, (int)blockIdx.x); S.reps = GREP3;
          EpiRes E{xn, lds + pg8::STAGE_BYTES};
          pg8::gemm_phase<EpiRes, pg8::StaticOrder, true, true>(lds, g, S, E); }
    }
    SEAM(3);
    if (IN(4)) {
#ifdef P4DELAY
        if ((blockIdx.x >> 3) & 1) { const unsigned long long t0 = __builtin_amdgcn_s_memrealtime(); while (__builtin_amdgcn_s_memrealtime() - t0 < P4DELAY) __builtin_amdgcn_s_sleep(8); }
#endif
        pg8::Gemm g{xn, (const bf16*)(ws + WS_WGATE), MTOK, DM, DM}; pg8::StaticOrder S; S.init(MTOK, DM, G, (int)blockIdx.x); S.reps = GREP4; S.rev = (GREP4 == 1 && G == 256) ? 5 : 0;
        EpiGate E{ple, xn, a.out, (float*)(ws + WS_PROJ), lds + pg8::STAGE_BYTES};
#ifndef P4_ALIGN
#define P4_ALIGN true
#endif
        pg8::gemm_phase<EpiGate, pg8::StaticOrder, P4_ALIGN, true, true>(lds, g, S, E);
    }
#undef IN
#undef SEAM
}

#ifndef N_LAUNCHES
#define N_LAUNCHES 1
#endif
extern "C" void kernel_launch(void* const* d_in, const int* in_sizes, int n_in, void* d_out, int out_size, void* d_ws, size_t ws_size, hipStream_t stream) {
    static int grid = 0;
    if (grid == 0) {
        if (ws_size < WS_END) { fprintf(stderr, "kernel_launch: workspace too small (%zu < %zu)\n", ws_size, (size_t)WS_END); grid = -1; return; }
        int dev = 0, cus = 0, per_cu = 0;
        hipGetDevice(&dev);
        hipDeviceGetAttribute(&cus, hipDeviceAttributeMultiprocessorCount, dev);
        hipFuncSetAttribute((const void*)enc_fwd, hipFuncAttributeMaxDynamicSharedMemorySize, LDS_BYTES);
        hipOccupancyMaxActiveBlocksPerMultiprocessor(&per_cu, (const void*)enc_fwd, NTHREADS, LDS_BYTES);
        if (per_cu < 1) { fprintf(stderr, "kernel_launch: occupancy query says %d blocks per CU\n", per_cu); per_cu = 1; }
        grid = cus * 1;
        (void)hipGetLastError();
    }
    if (grid < 0) return;
    Params p{};
    p.xp = (const float*)d_in[0]; p.xs = (const float*)d_in[1]; p.pp = (const float*)d_in[2]; p.ps = (const float*)d_in[3];
    p.norm_w = (const float*)d_in[4]; p.w_in = (const float*)d_in[5]; p.qna = (const float*)d_in[6]; p.kna = (const float*)d_in[7]; p.sink = (const float*)d_in[8];
    p.qnb = (const float*)d_in[9]; p.knb = (const float*)d_in[10]; p.rpb = (const float*)d_in[11]; p.w_out = (const float*)d_in[12]; p.w_ple = (const float*)d_in[13]; p.w_gate = (const float*)d_in[14];
    p.out = (float*)d_out; p.ws = (unsigned char*)d_ws;
    hipMemsetAsync((char*)d_ws + WS_CTL, 0, CTL_BYTES, stream);
#if N_LAUNCHES == 1
    p.ph_lo = 0; p.ph_hi = 5;
    void* args[] = {&p};
    hipError_t e = hipLaunchCooperativeKernel((const void*)enc_fwd, dim3(grid), dim3(NTHREADS), args, LDS_BYTES, stream);
    if (e != hipSuccess) fprintf(stderr, "cooperative launch failed: %s (grid %d)\n", hipGetErrorString(e), grid);
#else
    for (int ph = 0; ph < 5; ++ph) { p.ph_lo = ph; p.ph_hi = ph + 1; hipLaunchKernelGGL(enc_fwd, dim3(grid), dim3(NTHREADS), LDS_BYTES, stream, p); }
#endif
}
```

```cpp
#include <hip/hip_runtime.h>
#include <hip/hip_cooperative_groups.h>
#include <cstdio>
#include <cstdint>
#include <cmath>
namespace cg = cooperative_groups;
#ifndef PG8_WGM
#define PG8_WGM 4
#endif
namespace pg8 {
#define PG8_LAS __attribute__((address_space(3)))
typedef unsigned short bf16_t;
typedef short bf16x8 __attribute__((ext_vector_type(8)));
typedef float f32x4 __attribute__((ext_vector_type(4)));
typedef unsigned u32x4 __attribute__((ext_vector_type(4)));
constexpr int BM = 256, BK = 64, HALF = 128, HTB = HALF * BK * 2  , STAGE_BYTES = 8 * HTB, NXCD = 8, WGM = PG8_WGM;

__host__ __device__ __forceinline__ int lds_byte(int r, int c) { const int st = (r >> 4) * 2 + (c >> 5), rr = r & 15, cc = c & 31, ob = rr * 64 + cc * 2; return st * 1024 + (ob ^ (((ob >> 9) & 1) << 5)); }
__host__ __device__ __forceinline__ void stage_rc(int b, int& R, int& C) { const int st = b / 1024, sb = b % 1024, swz = sb ^ (((sb >> 9) & 1) << 5); R = (st >> 1) * 16 + swz / 64; C = (st & 1) * 32 + (swz % 64) / 2; }
__host__ __device__ __forceinline__ int perm32(int rho) { const int n = rho >> 4, i = rho & 15; return 8 * (i >> 2) + 4 * n + (i & 3); }

struct Unit { int pm, pn; };
struct Gemm { const bf16_t* A; const bf16_t* Bt; int M, N, K; };

struct StaticOrder {
    int nM, nN, nwg, G, c, reps = 1, i0 = 0, i1 = 1 << 30, rev = 0;
    __host__ __device__ void init(int M, int N, int G_, int c_) { nM = M / BM; nN = N / BM; nwg = nM * nN; G = G_; c = c_; }
    __host__ __device__ bool next(int ii, Unit& u) const {
        int i = ii + i0; if (i >= i1) return false;
        if (rev > 0) { if (i >= rev) return false; i = rev - 1 - i; }
        const long L = (long)i * G + c; if (L >= (long)nwg * reps) return false;
        int wgid = (int)(L % nwg); { const int q = nwg / NXCD, r = nwg % NXCD, xcd = wgid % NXCD, off = wgid / NXCD; wgid = (xcd < r ? xcd * (q + 1) : r * (q + 1) + (xcd - r) * q) + off; }
        const int nig = WGM * nN, gid = wgid / nig, fm = gid * WGM, gsz = (nM - fm) < WGM ? (nM - fm) : WGM;
        u.pm = fm + ((wgid % nig) % gsz); u.pn = (wgid % nig) / gsz; return true;
    }
    __device__ __forceinline__ void a_ready(const Unit&) const {}
    __device__ __forceinline__ void done(const Unit&) const {}
};

__device__ __forceinline__ unsigned cvt_pk_bf16(float lo, float hi) { unsigned r; asm volatile("v_cvt_pk_bf16_f32 %0, %1, %2" : "=v"(r) : "v"(lo), "v"(hi)); return r; }
typedef float f32x2 __attribute__((ext_vector_type(2)));
template <bool F16> __device__ __forceinline__ f32x4 mma16(bf16x8 a, bf16x8 b, f32x4 c) {
    if constexpr (F16) { typedef _Float16 h8 __attribute__((ext_vector_type(8))); return __builtin_amdgcn_mfma_f32_16x16x32_f16(__builtin_bit_cast(h8, a), __builtin_bit_cast(h8, b), c, 0, 0, 0); }
    else return __builtin_amdgcn_mfma_f32_16x16x32_bf16(a, b, c, 0, 0, 0);
}
template <class Epi, class Sched, bool ALIGN_EPI = false, bool SP2 = false, bool F16 = false>
__device__ __forceinline__ void gemm_phase(PG8_LAS unsigned char* lds, const Gemm g, const Sched& S, const Epi& E) {
    const int tid = threadIdx.x, wid = __builtin_amdgcn_readfirstlane(tid >> 6), lane = tid & 63, wr = wid >> 2, wc = wid & 3, fr = lane & 15, fq = lane >> 4;
    const int K = g.K, nt = K / BK;
    unsigned voffA[2], voffB[2];
#pragma unroll
    for (int i = 0; i < 2; ++i) { int R, C; stage_rc(tid * 16 + i * 8192, R, C); const int Rb = Epi::PERM ? ((R & ~31) + perm32(R & 31)) : R;
        voffA[i] = (unsigned)(R * K + C) * 2u; voffB[i] = (unsigned)(Rb * K + C) * 2u; }
    const size_t kstep = (size_t)(BK * 2);
    const size_t hstep = (size_t)HALF * K * 2;
    const size_t tstep = 2 * hstep;
    const unsigned ldsw = (unsigned)wid * 1024u;
    const int aoff = lds_byte(wr * 64 + fr, fq * 8), boff = lds_byte(wc * 32 + fr, fq * 8);
#define PG8_SA(b, h) (((b) * 2 + (h)) * HTB)
#define PG8_SB(b, h) ((4 + (b) * 2 + (h)) * HTB)
#define PG8_STAGE(bufoff, gbase, voff) do { _Pragma("unroll") for (int _i = 0; _i < 2; ++_i) \
        __builtin_amdgcn_global_load_lds((const unsigned*)((const char*)(gbase) + (voff)[_i]), (PG8_LAS unsigned*)(lds + (bufoff) + ldsw + _i * 8192), 16, 0, 0); } while (0)
#define PG8_LDA(dst, b, h) do { _Pragma("unroll") for (int m = 0; m < 4; ++m) _Pragma("unroll") for (int k = 0; k < 2; ++k) dst[m][k] = *(const PG8_LAS bf16x8*)(lds + PG8_SA(b, h) + aoff + m * 2048 + k * 1024); } while (0)
#define PG8_LDB(dst, b, h) do { _Pragma("unroll") for (int n = 0; n < 2; ++n) _Pragma("unroll") for (int k = 0; k < 2; ++k) dst[n][k] = *(const PG8_LAS bf16x8*)(lds + PG8_SB(b, h) + boff + n * 2048 + k * 1024); } while (0)
#define PG8_MMA(ai, bj, At, Bt) do { __builtin_amdgcn_s_setprio(1); _Pragma("unroll") for (int m = 0; m < 4; ++m) _Pragma("unroll") for (int n = 0; n < 2; ++n) _Pragma("unroll") for (int k = 0; k < 2; ++k) \
        acc[ai][bj][m][n] = mma16<F16>(Bt[n][k], At[m][k], acc[ai][bj][m][n]); __builtin_amdgcn_s_setprio(0); } while (0)
#define PG8_WAIT_V(n) asm volatile("s_waitcnt vmcnt(" #n ")" ::: "memory")
#define PG8_WAIT_L(n) asm volatile("s_waitcnt lgkmcnt(" #n ")" ::: "memory")
#define PG8_BAR __builtin_amdgcn_s_barrier()
#define PG8_SCHED __builtin_amdgcn_sched_barrier(0)
    Unit cur, nxt; int ui = 0;
    if (!S.next(0, cur)) return;
    f32x4 acc[2][2][4][2];
#pragma unroll
    for (int a = 0; a < 2; ++a)
#pragma unroll
        for (int b = 0; b < 2; ++b)
#pragma unroll
            for (int m = 0; m < 4; ++m)
#pragma unroll
                for (int n = 0; n < 2; ++n) acc[a][b][m][n] = (f32x4){0.f, 0.f, 0.f, 0.f};
    bf16x8 At[4][2], B0[2][2], B1[2][2];
    const char* cA = (const char*)g.A + (size_t)cur.pm * tstep; const char* cB = (const char*)g.Bt + (size_t)cur.pn * tstep;
    S.a_ready(cur);
    if constexpr (SP2) {
        PG8_STAGE(PG8_SB(0, 0), cB, voffB); PG8_STAGE(PG8_SB(0, 1), cB + hstep, voffB); PG8_STAGE(PG8_SA(0, 0), cA, voffA); PG8_STAGE(PG8_SA(0, 1), cA + hstep, voffA);
        if (wr == 1) PG8_BAR;
        PG8_WAIT_V(2); PG8_BAR;
        PG8_STAGE(PG8_SB(1, 0), cB + kstep, voffB); PG8_STAGE(PG8_SA(1, 0), cA + kstep, voffA); PG8_STAGE(PG8_SB(1, 1), cB + hstep + kstep, voffB);
        PG8_WAIT_V(6); PG8_BAR;
    } else {
        PG8_STAGE(PG8_SB(0, 0), cB, voffB); PG8_STAGE(PG8_SA(0, 0), cA, voffA); PG8_STAGE(PG8_SB(0, 1), cB + hstep, voffB); PG8_STAGE(PG8_SA(0, 1), cA + hstep, voffA);
        if (wr == 1) PG8_BAR;
        PG8_WAIT_V(4); PG8_BAR;
        PG8_STAGE(PG8_SB(1, 0), cB + kstep, voffB); PG8_STAGE(PG8_SA(1, 0), cA + kstep, voffA); PG8_STAGE(PG8_SB(1, 1), cB + hstep + kstep, voffB);
        PG8_WAIT_V(6); PG8_BAR;
    }
    for (;;) {
        const bool has_next = S.next(ui + 1, nxt);
        const char* nA = has_next ? (const char*)g.A + (size_t)nxt.pm * tstep : cA; const char* nB = has_next ? (const char*)g.Bt + (size_t)nxt.pn * tstep : cB;
#pragma unroll 1
        for (int t = 0; t < nt; t += 2) {
            const bool last = (t == nt - 2);
            if constexpr (Epi::KPF) E.kpf(cur, t >> 1, tid, lds + STAGE_BYTES);
            const char* a1 = cA + (size_t)(t + 1) * kstep;
            const char* a2 = last ? nA : cA + (size_t)(t + 2) * kstep; const char* b2 = last ? nB : cB + (size_t)(t + 2) * kstep;
            const char* a3 = a2 + kstep; const char* b3 = b2 + kstep;
            if (last && has_next) S.a_ready(nxt);
            if constexpr (SP2) {
            PG8_LDB(B0, 0, 0); PG8_LDB(B1, 0, 1); PG8_SCHED; PG8_LDA(At, 0, 0); PG8_STAGE(PG8_SA(1, 1), a1 + hstep, voffA);
            PG8_WAIT_V(8); PG8_WAIT_L(0); PG8_BAR; PG8_MMA(0, 0, At, B0); PG8_MMA(0, 1, At, B1); PG8_BAR; PG8_SCHED;
            PG8_LDA(At, 0, 1); PG8_STAGE(PG8_SB(0, 0), b2, voffB); PG8_STAGE(PG8_SB(0, 1), b2 + hstep, voffB); PG8_STAGE(PG8_SA(0, 0), a2, voffA);
            PG8_WAIT_V(8); PG8_WAIT_L(0); PG8_BAR; PG8_MMA(1, 0, At, B0); PG8_MMA(1, 1, At, B1); PG8_BAR; PG8_SCHED;
            PG8_LDB(B0, 1, 0); PG8_LDB(B1, 1, 1); PG8_SCHED; PG8_LDA(At, 1, 0); PG8_STAGE(PG8_SA(0, 1), a2 + hstep, voffA);
            PG8_WAIT_V(8); PG8_WAIT_L(0); PG8_BAR; PG8_MMA(0, 0, At, B0); PG8_MMA(0, 1, At, B1); PG8_BAR; PG8_SCHED;
            PG8_LDA(At, 1, 1); PG8_STAGE(PG8_SB(1, 0), b3, voffB); PG8_STAGE(PG8_SB(1, 1), b3 + hstep, voffB); PG8_STAGE(PG8_SA(1, 0), a3, voffA);
            PG8_WAIT_V(8); PG8_WAIT_L(0); PG8_BAR; PG8_MMA(1, 0, At, B0); PG8_MMA(1, 1, At, B1); PG8_BAR; PG8_SCHED;
            } else {
            PG8_LDB(B0, 0, 0); PG8_SCHED; PG8_LDA(At, 0, 0); PG8_STAGE(PG8_SA(1, 1), a1 + hstep, voffA);
            PG8_WAIT_L(8); PG8_BAR; PG8_WAIT_L(0); PG8_MMA(0, 0, At, B0); PG8_BAR; PG8_SCHED;
            PG8_LDB(B1, 0, 1); PG8_STAGE(PG8_SB(0, 0), b2, voffB);
            PG8_BAR; PG8_WAIT_L(0); PG8_MMA(0, 1, At, B1); PG8_BAR;
            PG8_LDA(At, 0, 1); PG8_STAGE(PG8_SA(0, 0), a2, voffA);
            PG8_BAR; PG8_WAIT_L(0); PG8_MMA(1, 0, At, B0); PG8_BAR; PG8_SCHED;
            PG8_STAGE(PG8_SB(0, 1), b2 + hstep, voffB);
            PG8_WAIT_V(6); PG8_BAR; PG8_MMA(1, 1, At, B1); PG8_BAR;
            PG8_LDB(B0, 1, 0); PG8_SCHED; PG8_LDA(At, 1, 0); PG8_STAGE(PG8_SA(0, 1), a2 + hstep, voffA);
            PG8_WAIT_L(8); PG8_BAR; PG8_WAIT_L(0); PG8_MMA(0, 0, At, B0); PG8_BAR; PG8_SCHED;
            PG8_LDB(B1, 1, 1); PG8_STAGE(PG8_SB(1, 0), b3, voffB);
            PG8_BAR; PG8_WAIT_L(0); PG8_MMA(0, 1, At, B1); PG8_BAR;
            PG8_LDA(At, 1, 1); PG8_STAGE(PG8_SA(1, 0), a3, voffA);
            PG8_BAR; PG8_WAIT_L(0); PG8_MMA(1, 0, At, B0); PG8_BAR; PG8_SCHED;
            PG8_STAGE(PG8_SB(1, 1), b3 + hstep, voffB);
            PG8_WAIT_V(6); PG8_BAR; PG8_MMA(1, 1, At, B1); PG8_BAR;
            }
        }
        if constexpr (ALIGN_EPI) { if (wr == 0) PG8_BAR; }
        if constexpr (!Epi::AFTER_DRAIN) { E(acc, cur, wr, wc, fr, fq); S.done(cur); }
        if (!has_next) break;
#pragma unroll
        for (int a = 0; a < 2; ++a)
#pragma unroll
            for (int b = 0; b < 2; ++b)
#pragma unroll
                for (int m = 0; m < 4; ++m)
#pragma unroll
                    for (int n = 0; n < 2; ++n) acc[a][b][m][n] = (f32x4){0.f, 0.f, 0.f, 0.f};
        cur = nxt; cA = nA; cB = nB; ++ui;
        if constexpr (ALIGN_EPI) { if (wr == 1) PG8_BAR; }
    }
    PG8_WAIT_V(0);
    if constexpr (!ALIGN_EPI) { if (wr == 0) PG8_BAR; }
    PG8_BAR;
    if constexpr (Epi::AFTER_DRAIN) { E.fused(acc, cur, wr, wc, fr, fq, lds, wid, lane); S.done(cur); }
#undef PG8_SA
#undef PG8_SB
#undef PG8_STAGE
#undef PG8_LDA
#undef PG8_LDB
#undef PG8_MMA
#undef PG8_WAIT_V
#undef PG8_WAIT_L
#undef PG8_BAR
#undef PG8_SCHED
}
}

#define LAS __attribute__((address_space(3)))
typedef unsigned short bf16;
typedef unsigned u32x4 __attribute__((ext_vector_type(4)));
typedef unsigned u32x2 __attribute__((ext_vector_type(2)));
typedef float f32x4 __attribute__((ext_vector_type(4)));
typedef short bf16x8 __attribute__((ext_vector_type(8)));
typedef short s16x4 __attribute__((ext_vector_type(4)));

constexpr int DM = 1024, SEQ = 2048, NBATCH = 40, MTOK = NBATCH * SEQ, MPROMPT = 32 * SEQ;
constexpr int NIN = 3328, PLE = 256;
constexpr int NPJ = 2048;
constexpr int C_QA = 0, C_GA = 512, C_QB = 1024, C_GB = 1536;
constexpr float EPS = 1e-6f, L2E = 1.4426950408889634f;
constexpr int NWAVES = 8, NTHREADS = 512;
constexpr int LDS_BYTES = 155648;

constexpr size_t WS_WIN = 0;
constexpr size_t WS_WOUT = WS_WIN + (size_t)NIN * DM * 2;
constexpr size_t WS_WGATE = WS_WOUT + (size_t)DM * DM * 2;
constexpr size_t WS_WPLE = WS_WGATE + (size_t)DM * DM * 2;
constexpr size_t WS_ROPE = WS_WPLE + (size_t)DM * PLE * 2;
constexpr size_t WS_RINV = WS_ROPE + 2048 * 16 * 4;
constexpr size_t WS_CTL = 15u << 20, CTL_BYTES = 16384;
constexpr size_t WS_XN = 16u << 20;
constexpr size_t WS_PBF = WS_XN + (size_t)MTOK * DM * 2;
constexpr size_t WS_PROJ = WS_PBF + (size_t)MTOK * PLE * 2;
constexpr size_t WS_KB = WS_PROJ + (size_t)MTOK * NPJ * 2;
constexpr size_t WS_VB = WS_KB + (size_t)MTOK * 512 * 2;
constexpr size_t WS_KA = WS_VB + (size_t)MTOK * 512 * 2;
constexpr size_t WS_VA = WS_KA + (size_t)MTOK * 128 * 2;
constexpr size_t WS_MIX = WS_VA + (size_t)MTOK * 128 * 2;
constexpr size_t WS_END = WS_MIX + (size_t)MTOK * DM * 2;
static_assert(WS_RINV + (size_t)MTOK * 4 <= WS_CTL && WS_CTL + CTL_BYTES <= WS_XN, "ws map");

__device__ __forceinline__ unsigned f2bf(float f) { unsigned u = __builtin_bit_cast(unsigned, f); return (u + 0x7fffu + ((u >> 16) & 1u)) >> 16; }
typedef float f32x2_t __attribute__((ext_vector_type(2))); typedef __bf16 bf16x2_t __attribute__((ext_vector_type(2)));
__device__ __forceinline__ unsigned pk2(float lo, float hi) { f32x2_t v = {lo, hi}; bf16x2_t b = __builtin_convertvector(v, bf16x2_t); return __builtin_bit_cast(unsigned, b); }
typedef _Float16 f16x2_t __attribute__((ext_vector_type(2)));
__device__ __forceinline__ unsigned pkh2(float lo, float hi) { f32x2_t v = {lo, hi}; f16x2_t h = __builtin_convertvector(v, f16x2_t); return __builtin_bit_cast(unsigned, h); }
__device__ __forceinline__ float hlo(unsigned v) { return (float)__builtin_bit_cast(f16x2_t, v)[0]; }
__device__ __forceinline__ float hhi(unsigned v) { return (float)__builtin_bit_cast(f16x2_t, v)[1]; }
__device__ __forceinline__ float bf2f(unsigned short v) { return __builtin_bit_cast(float, (unsigned)v << 16); }
__device__ __forceinline__ float bflo(unsigned v) { return __builtin_bit_cast(float, v << 16); }
__device__ __forceinline__ float bfhi(unsigned v) { return __builtin_bit_cast(float, v & 0xffff0000u); }
__device__ __forceinline__ float fast_exp2(float x) { return __builtin_amdgcn_exp2f(x); }
__device__ __forceinline__ float fast_rcp(float x) { return __builtin_amdgcn_rcpf(x); }
__device__ __forceinline__ float sigmoidf_(float x) { return fast_rcp(1.0f + fast_exp2(-x * L2E)); }

struct EpiProj {
    static constexpr bool PERM = true, AFTER_DRAIN = false, KPF = false;
    PG8_LAS unsigned char* stg; bf16* P; bf16* KA; bf16* VA; bf16* KB; bf16* VB; const float* rinv; const float* qna; const float* kna; const float* qnb; const float* knb; const float* rope;
    __device__ __forceinline__ void operator()(const f32x4 (&acc)[2][2][4][2], const pg8::Unit& u, int wr, int wc, int fr, int fq) const {
        const int pn = u.pn;
        int type = 0; const float* nw = qna; bool rope_on = false; float sc = 1.f;
        bf16* dst = P; int hm_heads = 0, hm_head = 0, tcol = 0;
        if (pn <= 1) { type = 2; nw = qna; rope_on = true; sc = 0.125f; tcol = C_QA + pn * 256 + 64 * wc; }
        else if (pn == 2) { if (wc < 2) { type = 2; nw = kna; rope_on = true; dst = KA; hm_heads = 2; hm_head = wc; } else { dst = VA; hm_heads = 2; hm_head = wc - 2; } }
        else if (pn <= 4) { type = 1; tcol = C_GA + (pn - 3) * 256 + 64 * wc; }
        else if (pn <= 6) { type = 2; nw = qnb; sc = 0.125f; tcol = C_QB + (pn - 5) * 256 + 64 * wc; }
        else if (pn <= 8) { type = 2; nw = knb; dst = KB; hm_heads = 8; hm_head = (pn - 7) * 4 + wc; }
        else if (pn <= 10) { dst = VB; hm_heads = 8; hm_head = (pn - 9) * 4 + wc; }
        else { type = 1; tcol = C_GB + (pn - 11) * 256 + 64 * wc; }
        f32x4 w[2][2];
#pragma unroll
        for (int bj = 0; bj < 2; ++bj)
#pragma unroll
            for (int n = 0; n < 2; ++n) w[bj][n] = *(const f32x4*)(nw + 32 * bj + 8 * fq + 4 * n) * sc;
        float rsv[2][4];
#pragma unroll
        for (int ai = 0; ai < 2; ++ai)
#pragma unroll
            for (int m = 0; m < 4; ++m) rsv[ai][m] = rinv[u.pm * 256 + ai * 128 + wr * 64 + m * 16 + fr];
        f32x4 rc[2][2], rsn[2][2];
        if (rope_on) { const float* rp = rope + ((u.pm * 256 + wr * 64 + fr) & (SEQ - 1)) * 16;
#pragma unroll
            for (int n = 0; n < 2; ++n) { rc[0][n] = *(const f32x4*)(rp + 4 * n); rsn[0][n] = *(const f32x4*)(rp + 8 + 4 * n); } }
#pragma unroll
        for (int ai = 0; ai < 2; ++ai)
#pragma unroll
            for (int m = 0; m < 4; ++m) {
                const int row = u.pm * 256 + ai * 128 + wr * 64 + m * 16 + fr;
                const float rs = rsv[ai][m];
                f32x4 v[2][2];
#pragma unroll
                for (int bj = 0; bj < 2; ++bj)
#pragma unroll
                    for (int n = 0; n < 2; ++n) v[bj][n] = acc[ai][bj][m][n] * rs;
                if (type == 2) {
                    float ss = 0.f;
#pragma unroll
                    for (int bj = 0; bj < 2; ++bj)
#pragma unroll
                        for (int n = 0; n < 2; ++n) { const f32x4 x = v[bj][n]; ss += (x[0] * x[0] + x[1] * x[1]) + (x[2] * x[2] + x[3] * x[3]); }
                    ss += __shfl_xor(ss, 16); ss += __shfl_xor(ss, 32);
                    const float rinv = __builtin_amdgcn_rsqf(ss * (1.0f / 64.0f) + EPS);
#pragma unroll
                    for (int bj = 0; bj < 2; ++bj)
#pragma unroll
                        for (int n = 0; n < 2; ++n) v[bj][n] = v[bj][n] * rinv * w[bj][n];
                    if (rope_on) {
                        constexpr int dummy_ = 0; (void)dummy_;
                        const int it = ai * 4 + m;
                        if (it < 7) { const int nai = (it + 1) >> 2, nm = (it + 1) & 3; const float* rpn = rope + ((u.pm * 256 + nai * 128 + wr * 64 + nm * 16 + fr) & (SEQ - 1)) * 16;
#pragma unroll
                            for (int n = 0; n < 2; ++n) { rc[(it + 1) & 1][n] = *(const f32x4*)(rpn + 4 * n); rsn[(it + 1) & 1][n] = *(const f32x4*)(rpn + 8 + 4 * n); } }
#pragma unroll
                        for (int n = 0; n < 2; ++n) {
                            const f32x4 c = rc[it & 1][n], s = rsn[it & 1][n];
                            f32x4 pv;
#pragma unroll
                            for (int e = 0; e < 4; ++e) pv[e] = __shfl_xor(v[0][n][e], 16);
                            if (fq == 0) v[0][n] = v[0][n] * c - pv * s;
                            else if (fq == 1) v[0][n] = v[0][n] * c + pv * s;
                        }
                    }
                } else if (type == 1) {
#pragma unroll
                    for (int bj = 0; bj < 2; ++bj)
#pragma unroll
                        for (int n = 0; n < 2; ++n)
#pragma unroll
                            for (int e = 0; e < 4; ++e) { const float x = v[bj][n][e]; v[bj][n][e] = x * sigmoidf_(x); }
                }
                { PG8_LAS unsigned char* my = stg + (wr * 4 + wc) * 2304; const int ln = fq * 16 + fr;
#pragma unroll
                  for (int bj = 0; bj < 2; ++bj) {
                      u32x4 o; o.x = pk2(v[bj][0][0], v[bj][0][1]); o.y = pk2(v[bj][0][2], v[bj][0][3]); o.z = pk2(v[bj][1][0], v[bj][1][1]); o.w = pk2(v[bj][1][2], v[bj][1][3]);
                      *(PG8_LAS u32x4*)(my + fr * 144 + bj * 64 + fq * 16) = o; }
                  const u32x4 r0 = *(const PG8_LAS u32x4*)(my + (ln >> 3) * 144 + (ln & 7) * 16), r1 = *(const PG8_LAS u32x4*)(my + ((ln >> 3) + 8) * 144 + (ln & 7) * 16);
                  const int rg = u.pm * 256 + ai * 128 + wr * 64 + m * 16 + (ln >> 3);
                  bf16* gp = hm_heads ? dst + ((size_t)((rg >> 11) * hm_heads + hm_head) * SEQ + (rg & (SEQ - 1))) * 64 + (ln & 7) * 8 : dst + (size_t)rg * NPJ + tcol + (ln & 7) * 8;
                  *(u32x4*)gp = r0; *(u32x4*)(gp + (hm_heads ? 8 * 64 : 8 * NPJ)) = r1; }
            }
    }
};
constexpr int PLE_LDR = 2 * DM;
struct EpiPlain {
    static constexpr bool PERM = true, AFTER_DRAIN = false, KPF = false;
    bf16* O; int ldc; PG8_LAS unsigned char* stg;
    __device__ __forceinline__ void operator()(const f32x4 (&acc)[2][2][4][2], const pg8::Unit& u, int wr, int wc, int fr, int fq) const {
        PG8_LAS unsigned char* my = stg + (wr * 4 + wc) * 2304; const int ln = fq * 16 + fr;
#pragma unroll
        for (int ai = 0; ai < 2; ++ai)
#pragma unroll
            for (int m = 0; m < 4; ++m) {
#pragma unroll
                for (int bj = 0; bj < 2; ++bj) { const f32x4 v0 = acc[ai][bj][m][0], v1 = acc[ai][bj][m][1];
                    u32x4 o; o.x = pk2(v0[0], v0[1]); o.y = pk2(v0[2], v0[3]); o.z = pk2(v1[0], v1[1]); o.w = pk2(v1[2], v1[3]);
                    *(PG8_LAS u32x4*)(my + fr * 144 + bj * 64 + fq * 16) = o; }
                const u32x4 r0 = *(const PG8_LAS u32x4*)(my + (ln >> 3) * 144 + (ln & 7) * 16), r1 = *(const PG8_LAS u32x4*)(my + ((ln >> 3) + 8) * 144 + (ln & 7) * 16);
                bf16* gp = O + (size_t)(u.pm * 256 + ai * 128 + wr * 64 + m * 16 + (ln >> 3)) * PLE_LDR + u.pn * 512 + wc * 128 + (ln & 7) * 8;
                *(u32x4*)gp = r0; *(u32x4*)(gp + (size_t)8 * PLE_LDR) = r1; }
    }
};
struct EpiRes {
    static constexpr bool PERM = true, AFTER_DRAIN = false, KPF = false;
    bf16* xh; PG8_LAS unsigned char* stg;
    __device__ __forceinline__ void operator()(const f32x4 (&acc)[2][2][4][2], const pg8::Unit& u, int wr, int wc, int fr, int fq) const {
        PG8_LAS unsigned char* my = stg + (wr * 4 + wc) * 2304; const int ln = fq * 16 + fr;
        bf16* sbase = xh + (size_t)(u.pm * 256 + wr * 64 + (ln >> 3)) * DM + u.pn * 256 + wc * 64 + (ln & 7) * 8;
        u32x4 xl[4][2], res[4][2];
#pragma unroll
        for (int m = 0; m < 4; ++m) { xl[m][0] = *(const u32x4*)(sbase + (size_t)(m * 16) * DM); xl[m][1] = *(const u32x4*)(sbase + (size_t)(m * 16 + 8) * DM); }
#pragma unroll
        for (int ai = 0; ai < 2; ++ai) {
#pragma unroll
            for (int m = 0; m < 4; ++m) {
                *(PG8_LAS u32x4*)(my + (ln >> 3) * 144 + (ln & 7) * 16) = xl[m][0]; *(PG8_LAS u32x4*)(my + ((ln >> 3) + 8) * 144 + (ln & 7) * 16) = xl[m][1];
#pragma unroll
                for (int bj = 0; bj < 2; ++bj) { const u32x4 x4 = *(const PG8_LAS u32x4*)(my + fr * 144 + bj * 64 + fq * 16);
                    const f32x4 a0 = acc[ai][bj][m][0], a1 = acc[ai][bj][m][1];
                    u32x4 w; w.x = pkh2(hlo(x4.x) + a0[0], hhi(x4.x) + a0[1]); w.y = pkh2(hlo(x4.y) + a0[2], hhi(x4.y) + a0[3]);
                    w.z = pkh2(hlo(x4.z) + a1[0], hhi(x4.z) + a1[1]); w.w = pkh2(hlo(x4.w) + a1[2], hhi(x4.w) + a1[3]); res[m][bj] = w; }
            }
            if (ai == 0) {
#pragma unroll
                for (int m = 0; m < 4; ++m) { xl[m][0] = *(const u32x4*)(sbase + (size_t)(128 + m * 16) * DM); xl[m][1] = *(const u32x4*)(sbase + (size_t)(128 + m * 16 + 8) * DM); }
            }
            asm volatile("" ::: "memory");
#pragma unroll
            for (int m = 0; m < 4; ++m) {
                *(PG8_LAS u32x4*)(my + fr * 144 + fq * 16) = res[m][0]; *(PG8_LAS u32x4*)(my + fr * 144 + 64 + fq * 16) = res[m][1];
                const u32x4 r0 = *(const PG8_LAS u32x4*)(my + (ln >> 3) * 144 + (ln & 7) * 16), r1 = *(const PG8_LAS u32x4*)(my + ((ln >> 3) + 8) * 144 + (ln & 7) * 16);
                bf16* gp = sbase + (size_t)(ai * 128 + m * 16) * DM;
                *(u32x4*)gp = r0; *(u32x4*)(gp + 8 * DM) = r1; }
            asm volatile("" ::: "memory");
        }
    }
};
struct EpiGate {
#ifndef GATE_PERM
#define GATE_PERM 1
#endif
    static constexpr bool PERM = (GATE_PERM != 0), AFTER_DRAIN = false, KPF = false;
    const bf16* ple; const bf16* xh; float* out; float* dup; PG8_LAS unsigned char* stg;
    __device__ __forceinline__ void operator()(const f32x4 (&acc)[2][2][4][2], const pg8::Unit& u, int wr, int wc, int fr, int fq) const {
        if constexpr (PERM) {
        PG8_LAS unsigned char* my = stg + (wr * 4 + wc) * 2304; const int ln = fq * 16 + fr;
        const size_t lbase = (size_t)(u.pm * 256 + wr * 64 + (ln >> 3)) * DM + u.pn * 256 + wc * 64 + (ln & 7) * 8;
        const size_t pbase_ = (size_t)(u.pm * 256 + wr * 64 + (ln >> 3)) * PLE_LDR + u.pn * 512 + wc * 128 + (ln & 7) * 8;
        u32x4 xl[4][2], pl[4][2]; f32x4 res[4][2][2];
#pragma unroll
        for (int m = 0; m < 4; ++m) { const size_t off = lbase + (size_t)(m * 16) * DM, poff = pbase_ + (size_t)(m * 16) * PLE_LDR;
            xl[m][0] = *(const u32x4*)(xh + off); xl[m][1] = *(const u32x4*)(xh + off + 8 * DM); pl[m][0] = *(const u32x4*)(ple + poff); pl[m][1] = *(const u32x4*)(ple + poff + 8 * PLE_LDR); }
#pragma unroll
        for (int ai = 0; ai < 2; ++ai) {
#pragma unroll
            for (int m = 0; m < 4; ++m) {
                u32x4 xw[2], pw[2];
                *(PG8_LAS u32x4*)(my + (ln >> 3) * 144 + (ln & 7) * 16) = xl[m][0]; *(PG8_LAS u32x4*)(my + ((ln >> 3) + 8) * 144 + (ln & 7) * 16) = xl[m][1];
                xw[0] = *(const PG8_LAS u32x4*)(my + fr * 144 + fq * 16); xw[1] = *(const PG8_LAS u32x4*)(my + fr * 144 + 64 + fq * 16);
                *(PG8_LAS u32x4*)(my + (ln >> 3) * 144 + (ln & 7) * 16) = pl[m][0]; *(PG8_LAS u32x4*)(my + ((ln >> 3) + 8) * 144 + (ln & 7) * 16) = pl[m][1];
                pw[0] = *(const PG8_LAS u32x4*)(my + fr * 144 + fq * 16); pw[1] = *(const PG8_LAS u32x4*)(my + fr * 144 + 64 + fq * 16);
#pragma unroll
                for (int bj = 0; bj < 2; ++bj) {
                    const f32x4 a0 = acc[ai][bj][m][0], a1 = acc[ai][bj][m][1]; const u32x4 p4 = pw[bj], x4 = xw[bj];
                    f32x4 o0, o1;
                    o0[0] = hlo(x4.x) + bflo(p4.x) * sigmoidf_(a0[0]); o0[1] = hhi(x4.x) + bfhi(p4.x) * sigmoidf_(a0[1]);
                    o0[2] = hlo(x4.y) + bflo(p4.y) * sigmoidf_(a0[2]); o0[3] = hhi(x4.y) + bfhi(p4.y) * sigmoidf_(a0[3]);
                    o1[0] = hlo(x4.z) + bflo(p4.z) * sigmoidf_(a1[0]); o1[1] = hhi(x4.z) + bfhi(p4.z) * sigmoidf_(a1[1]);
                    o1[2] = hlo(x4.w) + bflo(p4.w) * sigmoidf_(a1[2]); o1[3] = hhi(x4.w) + bfhi(p4.w) * sigmoidf_(a1[3]);
                    res[m][bj][0] = o0; res[m][bj][1] = o1; }
            }
            if (ai == 0) {
#pragma unroll
                for (int m = 0; m < 4; ++m) { const size_t off = lbase + (size_t)(128 + m * 16) * DM, poff = pbase_ + (size_t)(128 + m * 16) * PLE_LDR;
                    xl[m][0] = *(const u32x4*)(xh + off); xl[m][1] = *(const u32x4*)(xh + off + 8 * DM); pl[m][0] = *(const u32x4*)(ple + poff); pl[m][1] = *(const u32x4*)(ple + poff + 8 * PLE_LDR); }
            }
            asm volatile("" ::: "memory");
#pragma unroll
            for (int m = 0; m < 4; ++m)
#pragma unroll
                for (int bj = 0; bj < 2; ++bj) {
                    *(PG8_LAS f32x4*)(my + fr * 144 + fq * 32) = res[m][bj][0]; *(PG8_LAS f32x4*)(my + fr * 144 + fq * 32 + 16) = res[m][bj][1];
                    const f32x4 r0 = *(const PG8_LAS f32x4*)(my + (ln >> 3) * 144 + (ln & 7) * 16), r1 = *(const PG8_LAS f32x4*)(my + ((ln >> 3) + 8) * 144 + (ln & 7) * 16);
                    float* gp = out + (size_t)(u.pm * 256 + ai * 128 + wr * 64 + m * 16 + (ln >> 3)) * DM + u.pn * 256 + wc * 64 + bj * 32 + (ln & 7) * 4;
                    *(f32x4*)gp = r0; *(f32x4*)(gp + 8 * DM) = r1; }
            asm volatile("" ::: "memory");
        }
        } else {
        const int row0 = u.pm * 256 + wr * 64 + fr, col0 = u.pn * 256 + wc * 32 + 4 * fq;
        float* obase = out + (size_t)row0 * DM + col0; const bf16* hbase = xh + (size_t)row0 * DM + col0; const bf16* pbase = ple + (size_t)row0 * DM + col0;
#pragma unroll
        for (int ai = 0; ai < 2; ++ai) {
            u32x2 xw[4][2][2], pw[4][2][2];
#pragma unroll
            for (int m = 0; m < 4; ++m)
#pragma unroll
                for (int bj = 0; bj < 2; ++bj)
#pragma unroll
                    for (int n = 0; n < 2; ++n) { const size_t off = (size_t)(ai * 128 + m * 16) * DM + bj * 128 + n * 16; xw[m][bj][n] = *(const u32x2*)(hbase + off); pw[m][bj][n] = *(const u32x2*)(pbase + off); }
#pragma unroll
            for (int m = 0; m < 4; ++m)
#pragma unroll
                for (int bj = 0; bj < 2; ++bj)
#pragma unroll
                    for (int n = 0; n < 2; ++n) { const size_t off = (size_t)(ai * 128 + m * 16) * DM + bj * 128 + n * 16;
                        const f32x4 a0 = acc[ai][bj][m][n]; const u32x2 p2 = pw[m][bj][n], x2 = xw[m][bj][n];
                        f32x4 o0;
                        o0[0] = hlo(x2.x) + bflo(p2.x) * sigmoidf_(a0[0]); o0[1] = hhi(x2.x) + bfhi(p2.x) * sigmoidf_(a0[1]);
                        o0[2] = hlo(x2.y) + bflo(p2.y) * sigmoidf_(a0[2]); o0[3] = hhi(x2.y) + bfhi(p2.y) * sigmoidf_(a0[3]);
                        *(f32x4*)(obase + off) = o0; }
            asm volatile("" ::: "memory");
        }
        }
    }
};

template <bool F16 = false> __device__ __forceinline__ void transpose_item(const float* W, int K, int N, bf16* WT, int k0, int n0, int dst_row0, LAS float* scr, int lane, const float* kscale = nullptr) {
    float wv[32];
#pragma unroll
    for (int i = 0; i < 32; ++i) { const int kk = 2 * i + (lane >> 5); wv[i] = W[(size_t)(k0 + kk) * N + n0 + (lane & 31)]; }
    if (kscale) {
#pragma unroll
        for (int i = 0; i < 32; ++i) wv[i] *= kscale[k0 + 2 * i + (lane >> 5)]; }
#pragma unroll
    for (int i = 0; i < 32; ++i) { const int kk = 2 * i + (lane >> 5); scr[kk * 33 + (lane & 31)] = wv[i]; }
    asm volatile("s_waitcnt lgkmcnt(0)" ::: "memory");
    const int c = lane & 7;
#pragma unroll
    for (int j = 0; j < 4; ++j) { const int n = (lane >> 3) + 8 * j; const LAS float* s = scr + (8 * c) * 33 + n;
        u32x4 o;
        if constexpr (F16) { o.x = pkh2(s[0 * 33], s[1 * 33]); o.y = pkh2(s[2 * 33], s[3 * 33]); o.z = pkh2(s[4 * 33], s[5 * 33]); o.w = pkh2(s[6 * 33], s[7 * 33]); }
        else { o.x = pk2(s[0 * 33], s[1 * 33]); o.y = pk2(s[2 * 33], s[3 * 33]); o.z = pk2(s[4 * 33], s[5 * 33]); o.w = pk2(s[6 * 33], s[7 * 33]); }
        *(u32x4*)(WT + (size_t)(dst_row0 + n) * K + k0 + 8 * c) = o; }
    asm volatile("s_waitcnt lgkmcnt(0)" ::: "memory");
}
__device__ __forceinline__ float wave_sum(float v) {
#pragma unroll
    for (int o = 1; o < 64; o <<= 1) v += __shfl_xor(v, o);
    return v;
}

__device__ __forceinline__ int grp_row0(int n0) { const int ga = (n0 & 255) >> 5; return (n0 & ~255) + 32 * (4 * (ga & 1) + (ga >> 1)); }
struct Params {
    const float* xp; const float* xs; const float* pp; const float* ps; const float* norm_w; const float* w_in;
    const float* qna; const float* kna; const float* sink; const float* qnb; const float* knb; const float* rpb;
    const float* w_out; const float* w_ple; const float* w_gate; float* out; unsigned char* ws;
    int ph_lo, ph_hi;
};

__device__ __forceinline__ void prologue(const Params& a, LAS unsigned char* lds, int tid, int lane, int wave, int G) {
    LAS float* scr = (LAS float*)(lds + wave * 16384);
    const int gw = blockIdx.x * NWAVES + wave, NGW = G * NWAVES;
    bf16* win_t = (bf16*)(a.ws + WS_WIN); bf16* wout_t = (bf16*)(a.ws + WS_WOUT); bf16* wgate_t = (bf16*)(a.ws + WS_WGATE); bf16* wple_t = (bf16*)(a.ws + WS_WPLE);
    constexpr int I_IN = (DM / 64) * (NIN / 32), I_SQ = (DM / 64) * (DM / 32), I_PLE = (PLE / 64) * (DM / 32);
    constexpr int NITEMS = I_IN + 2 * I_SQ + I_PLE;
    for (int it = gw; it < NITEMS; it += NGW) {
        int r = it;
        if (r < I_IN) { const int nblk = NIN / 32, kb = r / nblk, nb = r % nblk; const int n0 = 32 * nb; const int ga = (n0 & 255) >> 5, gl = 4 * (ga & 1) + (ga >> 1);
            transpose_item<true>(a.w_in, DM, NIN, win_t, 64 * kb, n0, (n0 & ~255) + 32 * gl, scr, lane, a.norm_w); continue; }
        r -= I_IN;
        if (r < I_SQ) { const int kb = r / 32, nb = r % 32; transpose_item(a.w_out, DM, DM, wout_t, 64 * kb, 32 * nb, grp_row0(32 * nb), scr, lane); continue; }
        r -= I_SQ;
        if (r < I_SQ) { const int kb = r / 32, nb = r % 32; transpose_item<true>(a.w_gate, DM, DM, wgate_t, 64 * kb, 32 * nb, grp_row0(32 * nb), scr, lane); continue; }
        r -= I_SQ;
        { const int kb = r / 32, nb = r % 32; transpose_item(a.w_ple, PLE, DM, wple_t, 64 * kb, 32 * nb, grp_row0(32 * nb), scr, lane); }
    }
    {
        float* rope = (float*)(a.ws + WS_ROPE);
        const double inv_freq[8] = {1.0, 0.19392274474868576, 0.03760603093086393, 0.007292664737217109, 0.001414213562373095, 0.0002742481756762073, 5.318295896944988e-05, 1.031338537721246e-05};
        for (int e = blockIdx.x * NTHREADS + tid; e < SEQ * 8; e += G * NTHREADS) {
            const int pos = e >> 3, i = e & 7;
            double f = 1.0;
#pragma unroll
            for (int k = 0; k < 8; ++k) f = (i == k) ? inv_freq[k] : f;
            double t = (double)pos * f * 0.15915494309189535; t -= __builtin_floor(t);
            const float tf = (float)t;
            rope[pos * 16 + i] = __builtin_amdgcn_cosf(tf); rope[pos * 16 + 8 + i] = __builtin_amdgcn_sinf(tf);
        }
    }
    {
        bf16* xh = (bf16*)(a.ws + WS_XN); float* rinv = (float*)(a.ws + WS_RINV);
        constexpr int RB = 4;
#define P0_ROW(M0, r) (gw + P0_PERM(((M0) - gw) / NGW + (r)) * NGW)
#define P0_PERM(tb) (permute ? (5 * ((tb) & 7) + 4 - ((tb) >> 3)) : (tb))
#define P0_LOAD(V, M0) do { _Pragma("unroll") for (int r = 0; r < RB; ++r) { const int m = ((M0) + r * NGW < MTOK) ? P0_ROW(M0, r) : MTOK; \
            if (m < MTOK) { const float* xrow = (m < MPROMPT) ? a.xp + (size_t)m * DM : a.xs + (size_t)(m - MPROMPT) * DM; const f32x4* xr = (const f32x4*)xrow + lane; \
                _Pragma("unroll") for (int j = 0; j < 4; ++j) V[r][j] = xr[64 * j]; } } } while (0)
#define P0_PROC(V, M0) do { _Pragma("unroll") for (int r = 0; r < RB; ++r) { const int m = ((M0) + r * NGW < MTOK) ? P0_ROW(M0, r) : MTOK; \
            if (m < MTOK) { float ss = 0.f; \
                _Pragma("unroll") for (int j = 0; j < 4; ++j) ss += (V[r][j][0] * V[r][j][0] + V[r][j][1] * V[r][j][1]) + (V[r][j][2] * V[r][j][2] + V[r][j][3] * V[r][j][3]); \
                ss = wave_sum(ss); \
                if (lane == 0) rinv[m] = 1.0f / sqrtf(ss * (1.0f / DM) + EPS); \
                u32x2* o8 = (u32x2*)(xh + (size_t)m * DM) + lane; \
                _Pragma("unroll") for (int j = 0; j < 4; ++j) { u32x2 w2; w2.x = pkh2(V[r][j][0], V[r][j][1]); w2.y = pkh2(V[r][j][2], V[r][j][3]); o8[64 * j] = w2; } } } } while (0)
        f32x4 va[RB][4], vb[RB][4];
        const bool permute = (NGW == SEQ);
        const int step = RB * NGW;
        P0_LOAD(va, gw);
        for (int m0 = gw; m0 < MTOK; m0 += 2 * step) {
            P0_LOAD(vb, m0 + step);
            asm volatile("" ::: "memory");
            P0_PROC(va, m0);
            asm volatile("" ::: "memory");
            P0_LOAD(va, m0 + 2 * step);
            asm volatile("" ::: "memory");
            P0_PROC(vb, m0 + step);
            asm volatile("" ::: "memory");
        }
#undef P0_LOAD
#undef P0_PROC
#undef P0_ROW
#undef P0_PERM
    }
    {
        bf16* pbf = (bf16*)(a.ws + WS_PBF);
        const size_t n4 = (size_t)MTOK * PLE / 4, np4 = (size_t)MPROMPT * PLE / 4, stride = (size_t)G * NTHREADS;
#define PB_LOAD(V, E0) do { _Pragma("unroll") for (int r = 0; r < 4; ++r) { const size_t e = (E0) + r * stride; if (e < n4) V[r] = (e < np4) ? ((const f32x4*)a.pp)[e] : ((const f32x4*)a.ps)[e - np4]; } } while (0)
#define PB_STORE(V, E0) do { _Pragma("unroll") for (int r = 0; r < 4; ++r) { const size_t e = (E0) + r * stride; if (e < n4) { u32x2 w2; w2.x = pk2(V[r][0], V[r][1]); w2.y = pk2(V[r][2], V[r][3]); ((u32x2*)pbf)[e] = w2; } } } while (0)
        f32x4 pa[4], pb[4];
        const size_t e00 = (size_t)blockIdx.x * NTHREADS + tid;
        PB_LOAD(pa, e00);
        for (size_t e0 = e00; e0 < n4; e0 += 8 * stride) {
            PB_LOAD(pb, e0 + 4 * stride);
            asm volatile("" ::: "memory");
            PB_STORE(pa, e0);
            asm volatile("" ::: "memory");
            PB_LOAD(pa, e0 + 8 * stride);
            asm volatile("" ::: "memory");
            PB_STORE(pb, e0 + 4 * stride);
            asm volatile("" ::: "memory");
        }
#undef PB_LOAD
#undef PB_STORE
    }
}

constexpr int KP = 144, VP = 160;
typedef short v4i16_t __attribute__((ext_vector_type(4)));
__device__ __forceinline__ s16x4 tr_read(const LAS unsigned char* p) { return __builtin_bit_cast(s16x4, __builtin_amdgcn_ds_read_tr16_b64_v4i16((LAS v4i16_t*)p)); }
__device__ __forceinline__ f32x4 mfma16(bf16x8 a, bf16x8 b, f32x4 c) { return __builtin_amdgcn_mfma_f32_16x16x32_bf16(a, b, c, 0, 0, 0); }

template <int NT, int VPITCH> __device__ __forceinline__ void softmax_pv_store(float (&S)[NT][4], float sink_term_valid, float sinkv, const LAS unsigned char* Vs, int vrow0, const int (&vrow)[(NT + 1) / 2],
                                                                   const u32x2 (&gatev)[4], bf16* out_ptr, int i16, int g) {
    float m = sink_term_valid != 0.f ? sinkv : -INFINITY;
#pragma unroll
    for (int t = 0; t < NT; ++t)
#pragma unroll
        for (int r = 0; r < 4; ++r) m = fmaxf(m, S[t][r]);
    m = fmaxf(m, __shfl_xor(m, 16)); m = fmaxf(m, __shfl_xor(m, 32));
    const float mb = m * L2E;
#pragma unroll
    for (int t = 0; t < NT; ++t)
#pragma unroll
        for (int r = 0; r < 4; ++r) S[t][r] = fast_exp2(S[t][r] * L2E - mb);
    f32x4 lsum = (f32x4){0.f, 0.f, 0.f, 0.f};
    const bf16x8 ones = (bf16x8){0x3f80, 0x3f80, 0x3f80, 0x3f80, 0x3f80, 0x3f80, 0x3f80, 0x3f80};
    f32x4 o[4];
#pragma unroll
    for (int dt = 0; dt < 4; ++dt) o[dt] = (f32x4){0.f, 0.f, 0.f, 0.f};
    const LAS unsigned char* vb = Vs + (vrow0 + 4 * g + (i16 >> 2)) * VPITCH + (i16 & 3) * 8;
    constexpr int NS = (NT + 1) / 2;
#pragma unroll
    for (int s = 0; s < NS; ++s) {
        u32x4 pw; pw.x = pk2(S[2 * s][0], S[2 * s][1]); pw.y = pk2(S[2 * s][2], S[2 * s][3]);
        if (2 * s + 1 < NT) { pw.z = pk2(S[(2 * s + 1) < NT ? 2 * s + 1 : 0][0], S[(2 * s + 1) < NT ? 2 * s + 1 : 0][1]); pw.w = pk2(S[(2 * s + 1) < NT ? 2 * s + 1 : 0][2], S[(2 * s + 1) < NT ? 2 * s + 1 : 0][3]); }
        else { pw.z = 0u; pw.w = 0u; }
        const bf16x8 pf = __builtin_bit_cast(bf16x8, pw);
#pragma unroll
        for (int dt = 0; dt < 4; ++dt) {
            const s16x4 lo = tr_read(vb + vrow[s] * VPITCH + dt * 32), hi = tr_read(vb + (vrow[s] + 16) * VPITCH + dt * 32);
            const bf16x8 vf = (bf16x8){lo[0], lo[1], lo[2], lo[3], hi[0], hi[1], hi[2], hi[3]};
            o[dt] = mfma16(vf, pf, o[dt]);
        }
        lsum = mfma16(ones, pf, lsum);
    }
    float l = lsum[0];
    if (sink_term_valid != 0.f) l += fast_exp2(sinkv * L2E - mb);
    const float inv = 1.0f / l;
#pragma unroll
    for (int dt = 0; dt < 4; ++dt) {
        const u32x2 gw = gatev[dt];
        u32x2 w2; w2.x = pk2(o[dt][0] * inv * bflo(gw.x), o[dt][1] * inv * bfhi(gw.x)); w2.y = pk2(o[dt][2] * inv * bflo(gw.y), o[dt][3] * inv * bfhi(gw.y));
        *(u32x2*)(out_ptr + dt * 16 + 4 * g) = w2;
    }
}

struct PfA { u32x4 k[7], v[7]; };
__device__ __forceinline__ void attnA_fetch(PfA& pf, const bf16* KA, const bf16* VA, int u, int tid) {
    const int kh = (u >> 3) & 1, j = ((u >> 4) + (u >> 8)) & 15, b = 5 * (u & 7) + 4 - (u >> 8), span0 = j * 128 - 128;
#pragma unroll
    for (int i = 0; i < 7; ++i) {
        const int c = tid + NTHREADS * i, row = c >> 3, ch = c & 7, kpos = span0 + row;
        pf.k[i] = (u32x4){0u, 0u, 0u, 0u}; pf.v[i] = (u32x4){0u, 0u, 0u, 0u};
        if (row < 384 && kpos >= 0 && kpos < SEQ) { const size_t o = ((size_t)(b * 2 + kh) * SEQ + kpos) * 64 + ch * 8; pf.k[i] = *(const u32x4*)(KA + o); pf.v[i] = *(const u32x4*)(VA + o); }
    }
}
__device__ __forceinline__ void attnA_commit(const PfA& pf, LAS unsigned char* lds, int tid) {
    LAS unsigned char* Ks = lds; LAS unsigned char* Vs = lds + 384 * KP;
#pragma unroll
    for (int i = 0; i < 7; ++i) {
        const int c = tid + NTHREADS * i, row = c >> 3, ch = c & 7;
        if (row < 384) *(LAS u32x4*)(Ks + row * KP + ch * 16) = pf.k[i];
        if (row < 400) *(LAS u32x4*)(Vs + row * VP + ch * 16) = pf.v[i];
    }
}
__device__ __forceinline__ void attnA_first(const bf16* proj, int u, int lane, int wave, bf16x8& qn0, bf16x8& qn1, u32x2 (&gnext)[4]) {
    const int kh = (u >> 3) & 1, j = ((u >> 4) + (u >> 8)) & 15, b = 5 * (u & 7) + 4 - (u >> 8); const int i16 = lane & 15, g = lane >> 4, head = kh * 4 + (wave >> 1);
    const size_t tok0 = (size_t)b * SEQ + j * 128 + (wave & 1) * 64 + i16; const bf16* qp = proj + tok0 * NPJ + C_QA + head * 64 + g * 8;
    qn0 = *(const bf16x8*)(qp); qn1 = *(const bf16x8*)(qp + 32);
#pragma unroll
    for (int dt = 0; dt < 4; ++dt) gnext[dt] = *(const u32x2*)(proj + tok0 * NPJ + C_GA + head * 64 + dt * 16 + 4 * g);
}
template <bool EDGE> __device__ __forceinline__ void attnA_compute(LAS unsigned char* lds, const bf16* proj, bf16* mix, const float* sink, int u, int lane, int wave, bf16x8 qn0, bf16x8 qn1, u32x2 (&gnext)[4]) {
    const int kh = (u >> 3) & 1, j = ((u >> 4) + (u >> 8)) & 15, b = 5 * (u & 7) + 4 - (u >> 8);
    const LAS unsigned char* Ks = lds; const LAS unsigned char* Vs = lds + 384 * KP;
    const int i16 = lane & 15, g = lane >> 4;
    const int head = kh * 4 + (wave >> 1);
    const float sinkv = sink[head];
#pragma unroll
    for (int i = 0; i < 4; ++i) {
        const int qt = (wave & 1) * 4 + i, q0 = j * 128 + qt * 16;
        const size_t tokq = (size_t)b * SEQ + q0 + i16;
        u32x2 gatev[4];
#pragma unroll
        for (int dt = 0; dt < 4; ++dt) gatev[dt] = gnext[dt];
        const bf16x8 qf0 = qn0, qf1 = qn1;
        float S[17][4];
        const LAS unsigned char* kb = Ks + (qt * 16 + i16) * KP + g * 16;
#pragma unroll
        for (int t = 0; t < 17; ++t) {
            const int kpos0 = q0 - 128 + 16 * t;
            if (!EDGE || (kpos0 >= 0 && kpos0 < SEQ)) {
                f32x4 acc = (f32x4){0.f, 0.f, 0.f, 0.f};
                acc = mfma16(*(const LAS bf16x8*)(kb + 16 * t * KP), qf0, acc);
                acc = mfma16(*(const LAS bf16x8*)(kb + 16 * t * KP + 64), qf1, acc);
#pragma unroll
                for (int r = 0; r < 4; ++r) S[t][r] = acc[r];
            } else {
#pragma unroll
                for (int r = 0; r < 4; ++r) S[t][r] = -INFINITY;
            }
        }
#pragma unroll
        for (int r = 0; r < 4; ++r) { if (4 * g + r < i16) S[0][r] = -INFINITY; if (4 * g + r > i16) S[16][r] = -INFINITY; }
        if (i < 3) { const bf16* qp = proj + (tokq + 16) * NPJ + C_QA + head * 64 + g * 8; qn0 = *(const bf16x8*)(qp); qn1 = *(const bf16x8*)(qp + 32);
#pragma unroll
            for (int dt = 0; dt < 4; ++dt) gnext[dt] = *(const u32x2*)(proj + (tokq + 16) * NPJ + C_GA + head * 64 + dt * 16 + 4 * g); }
        int vrow[9];
#pragma unroll
        for (int ks = 0; ks < 9; ++ks) vrow[ks] = 32 * ks;
        softmax_pv_store<17, VP>(S, 1.f, sinkv, Vs, qt * 16, vrow, gatev, mix + tokq * DM + head * 64, i16, g);
    }
}

__device__ __forceinline__ int clampi(int v, int lo, int hi) { return v < lo ? lo : (v > hi ? hi : v); }
constexpr int VPB = 144;
constexpr int B_RROWS = 512, B_VOFF = B_RROWS * KP, B_TOFF = B_VOFF + B_RROWS * VPB;
static_assert(B_TOFF + 2048 <= LDS_BYTES - 64 && 384 * KP + 400 * VP <= LDS_BYTES - 64, "LDS map");
struct PfB { u32x4 k[6], v[6]; float bias; bf16x8 q0, q1; u32x2 gate[4]; };
__device__ __forceinline__ void attnB_fetch(PfB& pf, const bf16* proj, const bf16* KB, const bf16* VB, const float* rpb, int w, int R, int tid) {
    const int n = (w >> 3) & 3, h = (w >> 5) & 7, b = 5 * (w & 7) + 4 - (w >> 8);
    const int nlo = (R == 0) ? 0 : (R == 1) ? 11 : (R == 2) ? 19 : 27, ncnt = (R == 0) ? 11 : (R == 3) ? 5 : 8;
    const int blk = clampi(16 * n - 8, 0, 32);
#pragma unroll
    for (int i = 0; i < 6; ++i) {
        const int c = tid + NTHREADS * i, rowi = c >> 8, kcol = (c >> 3) & 31, ch = c & 7;
        pf.k[i] = (u32x4){0u, 0u, 0u, 0u}; pf.v[i] = (u32x4){0u, 0u, 0u, 0u};
        if (rowi < ncnt) { const size_t o = ((size_t)(b * 8 + h) * SEQ + (nlo + rowi) * 64 + blk + kcol) * 64 + ch * 8; pf.k[i] = *(const u32x4*)(KB + o); pf.v[i] = *(const u32x4*)(VB + o); }
    }
    { const int idx = tid - 16; pf.bias = (idx >= 0 && idx < 465) ? rpb[h * 465 + idx] : 0.f; }
    { const int lane = tid & 63, wave = tid >> 6; const size_t tokq = (size_t)b * SEQ + (8 * R + wave) * 64 + 16 * n + (lane & 15);
      const bf16* qp = proj + tokq * NPJ + C_QB + h * 64 + (lane >> 4) * 8; pf.q0 = *(const bf16x8*)(qp); pf.q1 = *(const bf16x8*)(qp + 32);
#pragma unroll
      for (int dt = 0; dt < 4; ++dt) pf.gate[dt] = *(const u32x2*)(proj + tokq * NPJ + C_GB + h * 64 + dt * 16 + 4 * (lane >> 4)); }
}
__device__ __forceinline__ void attnB_commit(const PfB& pf, LAS unsigned char* lds, int R, int tid) {
    LAS unsigned char* Ks = lds; LAS unsigned char* Vs = lds + B_VOFF; LAS float* tbl = (LAS float*)(lds + B_TOFF);
    const int nlo = (R == 0) ? 0 : (R == 1) ? 11 : (R == 2) ? 19 : 27, ncnt = (R == 0) ? 11 : (R == 3) ? 5 : 8;
#pragma unroll
    for (int i = 0; i < 6; ++i) {
        const int c = tid + NTHREADS * i, rowi = c >> 8, kcol = (c >> 3) & 31, ch = c & 7;
        if (rowi < ncnt) { const int row = ((nlo + rowi) & 15) * 32 + kcol; *(LAS u32x4*)(Ks + row * KP + ch * 16) = pf.k[i]; *(LAS u32x4*)(Vs + row * VPB + ch * 16) = pf.v[i]; }
    }
    if (R == 0) tbl[tid] = pf.bias;
}
__device__ __forceinline__ void attnB_compute(LAS unsigned char* lds, bf16* mix, int w, int R, bf16x8 qf0, bf16x8 qf1, const u32x2 (&gatev)[4], int lane, int wave) {
    const int n = (w >> 3) & 3, h = (w >> 5) & 7, b = 5 * (w & 7) + 4 - (w >> 8);
    const LAS unsigned char* Ks = lds; const LAS unsigned char* Vs = lds + B_VOFF; const LAS float* tbl = (const LAS float*)(lds + B_TOFF);
    const int blk = clampi(16 * n - 8, 0, 32);
    const int i16 = lane & 15, g = lane >> 4;
    const int r = 8 * R + wave, rs = clampi(r - 4, 0, 24), c = 16 * n + i16, cs = clampi(c - 8, 0, 48);
    const size_t tokq = (size_t)b * SEQ + r * 64 + c;
    int vrow[8];
#pragma unroll
    for (int a = 0; a < 8; ++a) vrow[a] = ((rs + a) & 15) * 32;
    const int wloc = cs - blk;
    bool v0[4]; unsigned m01, m23;
#pragma unroll
    for (int rr = 0; rr < 4; ++rr) v0[rr] = (4 * g + rr) >= wloc;
    m01 = (v0[0] ? 0xffffu : 0u) | (v0[1] ? 0xffff0000u : 0u); m23 = (v0[2] ? 0xffffu : 0u) | (v0[3] ? 0xffff0000u : 0u);
    float Sm[8][4];
    const LAS unsigned char* kb = Ks + i16 * KP + g * 16;
    const LAS float* tb = tbl + 16 + (rs - r + 7) * 31 + (blk + 4 * g - c + 15);
#pragma unroll
    for (int a = 0; a < 8; ++a) {
        f32x4 acc0 = (f32x4){tb[a * 31 + 0], tb[a * 31 + 1], tb[a * 31 + 2], tb[a * 31 + 3]};
        f32x4 acc1 = (f32x4){tb[a * 31 + 16], tb[a * 31 + 17], tb[a * 31 + 18], tb[a * 31 + 19]};
        acc0 = mfma16(*(const LAS bf16x8*)(kb + vrow[a] * KP), qf0, acc0);
        acc0 = mfma16(*(const LAS bf16x8*)(kb + vrow[a] * KP + 64), qf1, acc0);
        acc1 = mfma16(*(const LAS bf16x8*)(kb + (vrow[a] + 16) * KP), qf0, acc1);
        acc1 = mfma16(*(const LAS bf16x8*)(kb + (vrow[a] + 16) * KP + 64), qf1, acc1);
#pragma unroll
        for (int rr = 0; rr < 4; ++rr) Sm[a][rr] = v0[rr] ? acc0[rr] : acc1[rr];
    }
    float m = -INFINITY;
#pragma unroll
    for (int a = 0; a < 8; ++a)
#pragma unroll
        for (int rr = 0; rr < 4; ++rr) m = fmaxf(m, Sm[a][rr]);
    m = fmaxf(m, __shfl_xor(m, 16)); m = fmaxf(m, __shfl_xor(m, 32));
    const float mb = m * L2E;
#pragma unroll
    for (int a = 0; a < 8; ++a)
#pragma unroll
        for (int rr = 0; rr < 4; ++rr) Sm[a][rr] = fast_exp2(Sm[a][rr] * L2E - mb);
    f32x4 lsum = (f32x4){0.f, 0.f, 0.f, 0.f};
    const bf16x8 ones = (bf16x8){0x3f80, 0x3f80, 0x3f80, 0x3f80, 0x3f80, 0x3f80, 0x3f80, 0x3f80};
    f32x4 o[4];
#pragma unroll
    for (int dt = 0; dt < 4; ++dt) o[dt] = (f32x4){0.f, 0.f, 0.f, 0.f};
    const LAS unsigned char* vb = Vs + (4 * g + (i16 >> 2)) * VPB + (i16 & 3) * 8;
#pragma unroll
    for (int a = 0; a < 8; ++a) {
        const unsigned p01 = pk2(Sm[a][0], Sm[a][1]), p23 = pk2(Sm[a][2], Sm[a][3]);
        u32x4 pw; pw.x = p01 & m01; pw.y = p23 & m23; pw.z = p01 & ~m01; pw.w = p23 & ~m23;
        const bf16x8 pf = __builtin_bit_cast(bf16x8, pw);
#pragma unroll
        for (int dt = 0; dt < 4; ++dt) {
            const s16x4 lo = tr_read(vb + vrow[a] * VPB + dt * 32), hi = tr_read(vb + (vrow[a] + 16) * VPB + dt * 32);
            const bf16x8 vf = (bf16x8){lo[0], lo[1], lo[2], lo[3], hi[0], hi[1], hi[2], hi[3]};
            o[dt] = mfma16(vf, pf, o[dt]);
        }
        lsum = mfma16(ones, pf, lsum);
    }
    const float inv = 1.0f / lsum[0];
    bf16* out_ptr = mix + tokq * DM + 512 + h * 64;
#pragma unroll
    for (int dt = 0; dt < 4; ++dt) {
        const u32x2 gw = gatev[dt];
        u32x2 w2; w2.x = pk2(o[dt][0] * inv * bflo(gw.x), o[dt][1] * inv * bfhi(gw.x)); w2.y = pk2(o[dt][2] * inv * bflo(gw.y), o[dt][3] * inv * bfhi(gw.y));
        *(u32x2*)(out_ptr + dt * 16 + 4 * g) = w2;
    }
}
__device__ __forceinline__ void attention_phase(LAS unsigned char* lds, const bf16* proj, const bf16* KA, const bf16* VA, const bf16* KB, const bf16* VB, bf16* mix, const float* sink, const float* rpb, int G, int tid, int lane, int wave) {
    constexpr int NA = NBATCH * 16 * 2, NBU = NBATCH * 8 * 4 * 4;
#ifndef REPA
#define REPA 1
#endif
#ifndef REPB
#define REPB 1
#endif
    for (int repa = 0; repa < REPA; ++repa) {
        int u = blockIdx.x; PfA pf;
        if (u < NA) attnA_fetch(pf, KA, VA, u, tid);
        for (; u < NA; u += G) {
            attnA_commit(pf, lds, tid);
            __syncthreads();
            bf16x8 qn0, qn1; u32x2 gfirst[4]; attnA_first(proj, u, lane, wave, qn0, qn1, gfirst);
            if (u + G < NA) attnA_fetch(pf, KA, VA, u + G, tid);
            { const int jj = ((u >> 4) + (u >> 8)) & 15; if (jj == 0 || jj == 15) attnA_compute<true>(lds, proj, mix, sink, u, lane, wave, qn0, qn1, gfirst); else attnA_compute<false>(lds, proj, mix, sink, u, lane, wave, qn0, qn1, gfirst); }
            __syncthreads();
        }
    }
    for (int repb = 0; repb < REPB; ++repb) {
        constexpr int NW = NBATCH * 8 * 4;
        int w = blockIdx.x, R = 0; PfB pf;
        if (w < NW) attnB_fetch(pf, proj, KB, VB, rpb, w, 0, tid);
        while (w < NW) {
            attnB_commit(pf, lds, R, tid);
            const bf16x8 qf0 = pf.q0, qf1 = pf.q1; u32x2 gatev[4];
#pragma unroll
            for (int dt = 0; dt < 4; ++dt) gatev[dt] = pf.gate[dt];
            __syncthreads();
            const int wn = (R == 3) ? w + G : w, Rn = (R + 1) & 3;
            if (wn < NW) attnB_fetch(pf, proj, KB, VB, rpb, wn, Rn, tid);
            attnB_compute(lds, mix, w, R, qf0, qf1, gatev, lane, wave);
            __syncthreads();
            w = wn; R = Rn;
        }
    }
}

#define XB_TMO      128
#define XB_XCNT(j)  (256  + 64 * (j))
#define XB_XSUB(j)  (1280 + 64 * (j))
#define XB_XGEN(j)  (2304 + 64 * (j))
#define XB_TOP      3328
#define XB_TOPGEN   3392
#define XCD_BAR_WORDS 3456
#define XB_SPIN_CAP (1u << 18)

__device__ __forceinline__ unsigned xb_ld(unsigned* p)              { return __hip_atomic_load(p, __ATOMIC_RELAXED, __HIP_MEMORY_SCOPE_AGENT); }
__device__ __forceinline__ unsigned xb_add(unsigned* p, unsigned v) { return __hip_atomic_fetch_add(p, v, __ATOMIC_RELAXED, __HIP_MEMORY_SCOPE_AGENT); }
__device__ __forceinline__ unsigned xb_xcc_id() { return (unsigned)__builtin_amdgcn_s_getreg((3 << 11) | 20) & 0xFu; }
#define XB_SPIN(cond, bar) do { unsigned _sp = 0; while (cond) { __builtin_amdgcn_s_sleep(1); \
    if ((++_sp & 255u) == 0u) { if (xb_ld(&(bar)[XB_TMO])) break; if (_sp > XB_SPIN_CAP) { atomicAdd(&(bar)[XB_TMO], 1u); break; } } } } while (0)

struct XcdBarrier {
    unsigned* bar; unsigned x;
    volatile LAS unsigned* st;
};

__device__ __forceinline__ XcdBarrier xcd_barrier_post(unsigned* bar, volatile LAS unsigned* st) {
    XcdBarrier b; b.bar = bar; b.x = xb_xcc_id(); b.st = st;
    if (threadIdx.x == 0) (void)xb_add(&bar[XB_XCNT(b.x)], 1u);
    return b;
}
__device__ __forceinline__ void xcd_barrier_complete(unsigned* bar, unsigned x, unsigned& nloc, unsigned& nx) {
    const unsigned G = gridDim.x * gridDim.y * gridDim.z;
    unsigned sum, cnt, mine, sp = 0u;
    for (;;) {
        sum = 0u; cnt = 0u; mine = 0u;
#pragma unroll
        for (unsigned j = 0; j < 16; ++j) { const unsigned c = xb_ld(&bar[XB_XCNT(j)]); sum += c; cnt += (c > 0u) ? 1u : 0u; mine = (j == x) ? c : mine; }
        if (sum == G) break;
        __builtin_amdgcn_s_sleep(1);
        if ((++sp & 255u) == 0u) { if (xb_ld(&bar[XB_TMO])) break; if (sp > XB_SPIN_CAP) { atomicAdd(&bar[XB_TMO], 1u); break; } }
    }
    nloc = mine > 0u ? mine : 1u; nx = cnt > 0u ? cnt : 1u;
}

__device__ __forceinline__ void xcd_barrier(const XcdBarrier& b) {
    asm volatile("s_waitcnt vmcnt(0)" ::: "memory");
    __syncthreads();
    if (threadIdx.x == 0) {
        unsigned* bar = b.bar;
        __builtin_amdgcn_s_waitcnt(0);
        unsigned nloc = b.st[0], nx = b.st[1];
        if (nloc == 0u) { xcd_barrier_complete(bar, b.x, nloc, nx); b.st[0] = nloc; b.st[1] = nx; }
        const unsigned old = xb_add(&bar[XB_XSUB(b.x)], 1u);
        const unsigned gen = old / nloc;
        if (old + 1u == (gen + 1u) * nloc) {
            __builtin_amdgcn_fence(__ATOMIC_RELEASE, "agent");
            asm volatile("s_waitcnt vmcnt(0)" ::: "memory");
            const unsigned og = xb_add(&bar[XB_TOP], 1u);
            const unsigned tg = og / nx;
            if (og + 1u == (tg + 1u) * nx) xb_add(&bar[XB_TOPGEN], 1u);
            else XB_SPIN(xb_ld(&bar[XB_TOPGEN]) == tg, bar);
            __builtin_amdgcn_fence(__ATOMIC_ACQUIRE, "agent");
            xb_add(&bar[XB_XGEN(b.x)], 1u);
            asm volatile("s_waitcnt vmcnt(0)" ::: "memory");
        } else {
            XB_SPIN(xb_ld(&bar[XB_XGEN(b.x)]) == gen, bar);
            __builtin_amdgcn_fence(__ATOMIC_ACQUIRE, "agent");
            asm volatile("s_waitcnt vmcnt(0)" ::: "memory");
        }
    }
    __syncthreads();
}

struct PleOrder {
    int c, G, phase;
    __device__ __forceinline__ bool next(int i, pg8::Unit& u) const {
        int idx;
        if (G == 256) { if (phase == 0) { if (c < 64) return false; idx = (c - 64) + 192 * i; if (idx >= 520) return false; } else { idx = 520 + c + 256 * i; if (idx >= 1280) return false; } }
        else { if (phase == 0) return false; idx = c + G * i; if (idx >= 1280) return false; }
        u.pm = idx >> 2; u.pn = idx & 3; return true;
    }
    __device__ __forceinline__ void a_ready(const pg8::Unit&) const {}
    __device__ __forceinline__ void done(const pg8::Unit&) const {}
};

__global__ void __launch_bounds__(NTHREADS, 2) enc_fwd(Params a) {
    extern __shared__ __attribute__((aligned(16))) unsigned char lds_raw[];
    LAS unsigned char* lds = (LAS unsigned char*)lds_raw;
    const int tid = threadIdx.x, lane = tid & 63, wave = __builtin_amdgcn_readfirstlane(tid >> 6);
    const int G = gridDim.x;
    cg::grid_group grid = cg::this_grid();
    volatile LAS unsigned* misc = (volatile LAS unsigned*)(lds + LDS_BYTES - 64);
    if (tid < 16) misc[tid] = 0u;
    __syncthreads();
    XcdBarrier xbar = xcd_barrier_post((unsigned*)(a.ws + WS_CTL), misc);
    if (a.ph_lo > 1000) grid.sync();
    unsigned char* ws = a.ws;
    bf16* xn = (bf16*)(ws + WS_XN); bf16* pbf = (bf16*)(ws + WS_PBF); bf16* proj = (bf16*)(ws + WS_PROJ); bf16* mix = (bf16*)(ws + WS_MIX); bf16* ple = (bf16*)a.out; float* x2f = (float*)(ws + WS_PROJ);
    const int lo = a.ph_lo, hi = a.ph_hi;
#ifdef PHASE_MASK
#define IN(k) (((PHASE_MASK >> (k)) & 1) && lo <= (k) && (k) < hi)
#else
#define IN(k) (lo <= (k) && (k) < hi)
#endif
#define SEAM(k) do { if (IN(k) && IN((k) + 1)) xcd_barrier(xbar); } while (0)
#ifndef GREP1
#define GREP1 1
#endif
#ifndef GREP3
#define GREP3 1
#endif
#ifndef GREP3B
#define GREP3B 1
#endif
#ifndef GREP4
#define GREP4 1
#endif
#ifndef REP0
#define REP0 1
#endif
#ifndef REP1
#define REP1 1
#endif
#ifndef REP2
#define REP2 1
#endif
#ifndef REP3
#define REP3 1
#endif
    if (IN(0)) for (int rep = 0; rep < REP0; ++rep) prologue(a, lds, tid, lane, wave, G);
    SEAM(0);
#ifdef XSYNC
    for (int q = 0; q < XSYNC; ++q) xcd_barrier(xbar);
#endif
    if (IN(1)) for (int rep = 0; rep < REP1; ++rep) {
        pg8::Gemm g{xn, (const bf16*)(ws + WS_WIN), MTOK, NIN, DM}; pg8::StaticOrder S; S.init(MTOK, NIN, G, (int)blockIdx.x); S.reps = GREP1;
        EpiProj E{lds + pg8::STAGE_BYTES, proj, (bf16*)(ws + WS_KA), (bf16*)(ws + WS_VA), (bf16*)(ws + WS_KB), (bf16*)(ws + WS_VB), (const float*)(ws + WS_RINV), a.qna, a.kna, a.qnb, a.knb, (const float*)(ws + WS_ROPE)};
#ifndef P1_SP2
#define P1_SP2 true
#endif
        pg8::gemm_phase<EpiProj, pg8::StaticOrder, true, P1_SP2, true>(lds, g, S, E);
        { pg8::Gemm gp{pbf, (const bf16*)(ws + WS_WPLE), MTOK, DM, PLE}; EpiPlain Ep{ple, DM, lds + pg8::STAGE_BYTES}; PleOrder SP{(int)blockIdx.x, G, 0};
          pg8::gemm_phase<EpiPlain, PleOrder, true, true>(lds, gp, SP, Ep); }
    }
    SEAM(1);
    if (IN(2)) for (int rep = 0; rep < REP2; ++rep) attention_phase(lds, proj, (const bf16*)(ws + WS_KA), (const bf16*)(ws + WS_VA), (const bf16*)(ws + WS_KB), (const bf16*)(ws + WS_VB), mix, a.sink, a.rpb, G, tid, lane, wave);
    if (IN(2)) { pg8::Gemm gp{pbf, (const bf16*)(ws + WS_WPLE), MTOK, DM, PLE}; EpiPlain Ep{ple, DM, lds + pg8::STAGE_BYTES}; PleOrder SP{(int)blockIdx.x, G, 1};
        __syncthreads();
        pg8::gemm_phase<EpiPlain, PleOrder, true, true>(lds, gp, SP, Ep); }
    SEAM(2);
    if (IN(3)) {
        { pg8::Gemm g{mix, (const bf16*)(ws + WS_WOUT), MTOK, DM, DM}; pg8::StaticOrder S; S.init(MTOK, DM, G, (int)blockIdx.x); S.reps = GREP3;
          EpiRes E{xn, lds + pg8::STAGE_BYTES};
          pg8::gemm_phase<EpiRes, pg8::StaticOrder, true, true>(lds, g, S, E); }
    }
    SEAM(3);
    if (IN(4)) {
#ifdef P4DELAY
        if ((blockIdx.x >> 3) & 1) { const unsigned long long t0 = __builtin_amdgcn_s_memrealtime(); while (__builtin_amdgcn_s_memrealtime() - t0 < P4DELAY) __builtin_amdgcn_s_sleep(8); }
#endif
        pg8::Gemm g{xn, (const bf16*)(ws + WS_WGATE), MTOK, DM, DM}; pg8::StaticOrder S; S.init(MTOK, DM, G, (int)blockIdx.x); S.reps = GREP4; S.rev = (GREP4 == 1 && G == 256) ? 5 : 0;
        EpiGate E{ple, xn, a.out, (float*)(ws + WS_PROJ), lds + pg8::STAGE_BYTES};
#ifndef P4_ALIGN
#define P4_ALIGN true
#endif
        pg8::gemm_phase<EpiGate, pg8::StaticOrder, P4_ALIGN, true, true>(lds, g, S, E);
    }
#undef IN
#undef SEAM
}

#ifndef N_LAUNCHES
#define N_LAUNCHES 1
#endif
extern "C" void kernel_launch(void* const* d_in, const int* in_sizes, int n_in, void* d_out, int out_size, void* d_ws, size_t ws_size, hipStream_t stream) {
    static int grid = 0;
    if (grid == 0) {
        if (ws_size < WS_END) { fprintf(stderr, "kernel_launch: workspace too small (%zu < %zu)\n", ws_size, (size_t)WS_END); grid = -1; return; }
        int dev = 0, cus = 0, per_cu = 0;
        hipGetDevice(&dev);
        hipDeviceGetAttribute(&cus, hipDeviceAttributeMultiprocessorCount, dev);
        hipFuncSetAttribute((const void*)enc_fwd, hipFuncAttributeMaxDynamicSharedMemorySize, LDS_BYTES);
        hipOccupancyMaxActiveBlocksPerMultiprocessor(&per_cu, (const void*)enc_fwd, NTHREADS, LDS_BYTES);
        if (per_cu < 1) { fprintf(stderr, "kernel_launch: occupancy query says %d blocks per CU\n", per_cu); per_cu = 1; }
        grid = cus * 1;
        (void)hipGetLastError();
    }
    if (grid < 0) return;
    Params p{};
    p.xp = (const float*)d_in[0]; p.xs = (const float*)d_in[1]; p.pp = (const float*)d_in[2]; p.ps = (const float*)d_in[3];
    p.norm_w = (const float*)d_in[4]; p.w_in = (const float*)d_in[5]; p.qna = (const float*)d_in[6]; p.kna = (const float*)d_in[7]; p.sink = (const float*)d_in[8];
    p.qnb = (const float*)d_in[9]; p.knb = (const float*)d_in[10]; p.rpb = (const float*)d_in[11]; p.w_out = (const float*)d_in[12]; p.w_ple = (const float*)d_in[13]; p.w_gate = (const float*)d_in[14];
    p.out = (float*)d_out; p.ws = (unsigned char*)d_ws;
    hipMemsetAsync((char*)d_ws + WS_CTL, 0, CTL_BYTES, stream);
#if N_LAUNCHES == 1
    p.ph_lo = 0; p.ph_hi = 5;
    void* args[] = {&p};
    hipError_t e = hipLaunchCooperativeKernel((const void*)enc_fwd, dim3(grid), dim3(NTHREADS), args, LDS_BYTES, stream);
    if (e != hipSuccess) fprintf(stderr, "cooperative launch failed: %s (grid %d)\n", hipGetErrorString(e), grid);
#else
    for (int ph = 0; ph < 5; ++ph) { p.ph_lo = ph; p.ph_hi = ph + 1; hipLaunchKernelGGL(enc_fwd, dim3(grid), dim3(NTHREADS), LDS_BYTES, stream, p); }
#endif
}
```
